# Optimizing an MI355X kernel written in HIP

```python
import math
import jax, jax.numpy as jnp
from jax import lax
import numpy as np

D_MODEL = 2048
BATCH = 4
SEQ = 4096
DEPTH = 1

D_MIX = D_MODEL
RET_HEADS = 4
RET_DK = 256
RET_DV = 256
RET_CHUNK = 128
ROPE_BASE = 10000.0
NSA_HEADS = 8
NSA_KV_GROUPS = 2
NSA_HPG = NSA_HEADS // NSA_KV_GROUPS
NSA_DH = 128
CMP_LEN = 32
CMP_STRIDE = 16
SEL_LEN = 64
SEL_TOPK = 16
SEL_Q_BLOCK = 64
WIN = 512
WIN_Q_BLOCK = 128
N_BRANCH = 3
REL_BUCKETS = 32
REL_MAX_DIST = 128
D_FF = 5632
EPS = 1e-6
NEG = -1e30
FORCE = 1e4

RET_W = RET_HEADS * RET_DV
NSA_W = NSA_HEADS * NSA_DH
KV_W = NSA_KV_GROUPS * NSA_DH
IN_SPLITS = [RET_HEADS * RET_DK, RET_HEADS * RET_DK, RET_W, RET_W, NSA_W,
             KV_W, KV_W, KV_W, KV_W, KV_W, KV_W, NSA_HEADS * N_BRANCH]
D_IN = sum(IN_SPLITS)

kernel_name = "hymba_retnet_nsa_macaron_block"


def rmsnorm(x, g):
    xf = x.astype(jnp.float32)
    y = xf * lax.rsqrt(jnp.mean(xf * xf, axis=-1, keepdims=True) + EPS)
    return (y * g.astype(jnp.float32)).astype(x.dtype)


def swiglu(x, w1, w3, w2):
    return (jax.nn.silu(x @ w1) * (x @ w3)) @ w2


def t5_bucket(rel):
    n = jnp.maximum(rel, 0)
    max_exact = REL_BUCKETS // 2
    nf = jnp.maximum(n, 1).astype(jnp.float32)
    large = max_exact + (jnp.log(nf / max_exact) / math.log(REL_MAX_DIST / max_exact)
                         * (REL_BUCKETS - max_exact)).astype(jnp.int32)
    large = jnp.minimum(large, REL_BUCKETS - 1)
    return jnp.where(n < max_exact, n, large)


def masked_softmax(logits, mask):
    p = jax.nn.softmax(jnp.where(mask, logits, NEG), axis=-1)
    return jnp.where(mask, p, 0.0)


def rotary(x, pos):
    half = x.shape[-1] // 2
    inv = ROPE_BASE ** (-jnp.arange(half, dtype=jnp.float32) / half)
    ang = pos.astype(jnp.float32)[:, None] * inv[None, :]
    cos = jnp.cos(ang)[None, :, None, :]
    sin = jnp.sin(ang)[None, :, None, :]
    xf = x.astype(jnp.float32)
    x1, x2 = xf[..., :half], xf[..., half:]
    return jnp.concatenate([x1 * cos - x2 * sin, x1 * sin + x2 * cos], axis=-1)


def retention(q, k, v):
    B, S, H, DK = q.shape
    DV = v.shape[-1]
    C = RET_CHUNK
    N = S // C
    log_g = jnp.log(1.0 - 2.0 ** (-5.0 - jnp.arange(H, dtype=jnp.float32)))
    idx = jnp.arange(C, dtype=jnp.float32)
    diff = idx[:, None] - idx[None, :]
    inner_decay = jnp.where(diff >= 0.0,
                            jnp.exp(jnp.maximum(diff, 0.0)[None] * log_g[:, None, None]), 0.0)
    xi = jnp.exp((idx + 1.0)[None] * log_g[:, None])
    zeta = jnp.exp((C - 1.0 - idx)[None] * log_g[:, None])
    chunk_decay = jnp.exp(C * log_g)
    qc = q.reshape(B, N, C, H, DK)
    kc = k.reshape(B, N, C, H, DK)
    vc = v.reshape(B, N, C, H, DV)
    s = jnp.einsum('bnchd,bnmhd->bnhcm', qc, kc) * inner_decay
    y_in = jnp.einsum('bnhcm,bnmhe->bnche', s, vc)
    u = jnp.einsum('bnmhd,bnmhe,hm->nbhde', kc, vc, zeta)

    def step(state, u_n):
        return chunk_decay[None, :, None, None] * state + u_n, state

    _, r_prev = lax.scan(step, jnp.zeros((B, H, DK, DV), jnp.float32), u)
    y_cross = jnp.einsum('bnchd,nbhde,hc->bnche', qc, r_prev, xi)
    return (y_in + y_cross).reshape(B, S, H, DV)


def compress(kv, pe, w1, w2, cmp_idx):
    blk = kv[:, :, cmp_idx] + pe.astype(kv.dtype)
    hdn = jax.nn.silu(jnp.einsum('bgnld,ldf->bgnf', blk, w1))
    return hdn @ w2


def nsa(q, kc_, vc_, ks_, vs_, kw_, vw_, gates, pe_k, w1_k, w2_k, pe_v, w1_v, w2_v, rel_bias):
    B, S, H, dh = q.shape
    G, hpg = NSA_KV_GROUPS, NSA_HPG
    scale = dh ** -0.5
    pos = jnp.arange(S, dtype=jnp.int32)
    qg = q.reshape(B, S, G, hpg, dh).transpose(0, 2, 3, 1, 4)
    to_g = lambda t: t.reshape(B, S, G, dh).transpose(0, 2, 1, 3)
    kc_, vc_, ks_, vs_, kw_, vw_ = map(to_g, (kc_, vc_, ks_, vs_, kw_, vw_))

    n_cmp = (S - CMP_LEN) // CMP_STRIDE + 1
    cmp_idx = np.arange(n_cmp)[:, None] * CMP_STRIDE + np.arange(CMP_LEN)[None, :]
    k_cmp = compress(kc_, pe_k, w1_k, w2_k, cmp_idx)
    v_cmp = compress(vc_, pe_v, w1_v, w2_v, cmp_idx)
    cmp_end = jnp.asarray(np.arange(n_cmp) * CMP_STRIDE + CMP_LEN - 1, jnp.int32)
    rel_c = pos[:, None] - cmp_end[None, :]
    bias_c = rel_bias.astype(jnp.float32)[:, t5_bucket(rel_c)].reshape(G, hpg, S, n_cmp)
    logit_c = jnp.einsum('bghsd,bgnd->bghsn', qg, k_cmp).astype(jnp.float32) * scale + bias_c
    p_cmp = masked_softmax(logit_c, rel_c >= 0)
    o_cmp = jnp.einsum('bghsn,bgnd->bghsd', p_cmp.astype(v_cmp.dtype), v_cmp)

    n_sel = S // SEL_LEN
    n_top = min(SEL_TOPK, n_sel)
    sel_of = cmp_idx // SEL_LEN
    overlap = jnp.asarray((sel_of[:, :, None] == np.arange(n_sel)[None, None, :]).sum(1)
                          .astype(np.float32) / CMP_LEN)
    imp = jnp.einsum('bghsn,nj->bgsj', p_cmp, overlap)
    blk = jnp.arange(n_sel, dtype=jnp.int32)
    cur = pos // SEL_LEN
    causal = (blk[None, :] * SEL_LEN) <= pos[:, None]
    forced = (blk[None, :] == 0) | (blk[None, :] == cur[:, None]) | (blk[None, :] == cur[:, None] - 1)
    score = jnp.where(forced, FORCE, jnp.where(causal, imp, NEG))
    top_val, top_idx = lax.top_k(score, n_top)
    top_ok = top_val > (NEG * 0.5)

    k_blocks = ks_.reshape(B, G, n_sel, SEL_LEN, dh)
    v_blocks = vs_.reshape(B, G, n_sel, SEL_LEN, dh)
    bi = jnp.arange(B)[:, None, None, None]
    gi = jnp.arange(G)[None, :, None, None]
    tbl_g = rel_bias.astype(jnp.float32).reshape(G, hpg, REL_BUCKETS).transpose(0, 2, 1)
    Qb = SEL_Q_BLOCK
    nq = S // Qb

    def sel_block(args):
        qb, idxb, okb, posb = args
        kg = k_blocks[bi, gi, idxb].reshape(B, G, Qb, n_top * SEL_LEN, dh)
        vg = v_blocks[bi, gi, idxb].reshape(B, G, Qb, n_top * SEL_LEN, dh)
        kpos = (idxb[..., None] * SEL_LEN + jnp.arange(SEL_LEN, dtype=jnp.int32)).reshape(B, G, Qb, -1)
        rel = posb[None, None, :, None] - kpos
        mask = jnp.repeat(okb, SEL_LEN, axis=-1) & (rel >= 0)
        bias = jnp.moveaxis(tbl_g[gi, t5_bucket(rel)], -1, 2)
        logits = jnp.einsum('bghqd,bgqkd->bghqk', qb, kg).astype(jnp.float32) * scale + bias
        p = masked_softmax(logits, mask[:, :, None])
        return jnp.einsum('bghqk,bgqkd->bghqd', p.astype(vg.dtype), vg)

    q_blocks = jnp.moveaxis(qg.reshape(B, G, hpg, nq, Qb, dh), 3, 0)
    idx_blocks = jnp.moveaxis(top_idx.reshape(B, G, nq, Qb, n_top), 2, 0)
    ok_blocks = jnp.moveaxis(top_ok.reshape(B, G, nq, Qb, n_top), 2, 0)
    pos_blocks = pos.reshape(nq, Qb)
    o_sel = lax.map(sel_block, (q_blocks, idx_blocks, ok_blocks, pos_blocks))
    o_sel = jnp.moveaxis(o_sel, 0, 3).reshape(B, G, hpg, S, dh)

    Wb = WIN_Q_BLOCK
    nb = S // Wb
    nw = WIN // Wb
    Kw = (nw + 1) * Wb

    def band(kv):
        padded = jnp.pad(kv, ((0, 0), (0, 0), (WIN, 0), (0, 0))).reshape(B, G, nb + nw, Wb, dh)
        return jnp.concatenate([padded[:, :, i:i + nb] for i in range(nw + 1)], axis=3)

    kwb, vwb = band(kw_), band(vw_)
    qi = np.arange(Wb)[:, None]
    kj = np.arange(Kw)[None, :]
    rel_w = qi + WIN - kj
    in_band = (rel_w >= 0) & (rel_w < WIN)
    real = (np.arange(nb)[:, None] * Wb + np.arange(Kw)[None, :] - WIN) >= 0
    mask_w = jnp.asarray(in_band[None] & real[:, None, :])
    bias_w = rel_bias.astype(jnp.float32)[:, t5_bucket(jnp.asarray(rel_w, jnp.int32))]
    bias_w = bias_w.reshape(G, hpg, 1, Wb, Kw)
    qw = qg.reshape(B, G, hpg, nb, Wb, dh)
    logit_w = jnp.einsum('bghnqd,bgnkd->bghnqk', qw, kwb).astype(jnp.float32) * scale + bias_w
    p_w = masked_softmax(logit_w, mask_w)
    o_win = jnp.einsum('bghnqk,bgnkd->bghnqd', p_w.astype(vwb.dtype), vwb).reshape(B, G, hpg, S, dh)

    g = jax.nn.sigmoid(gates.astype(jnp.float32)).reshape(B, S, G, hpg, N_BRANCH).transpose(0, 2, 3, 1, 4)
    o = (g[..., 0:1] * o_cmp.astype(jnp.float32) + g[..., 1:2] * o_sel.astype(jnp.float32)
         + g[..., 2:3] * o_win.astype(jnp.float32))
    return o.transpose(0, 3, 1, 2, 4).reshape(B, S, H * dh).astype(q.dtype)


def token_mix(h, w_in, ret_gn_gain, pe_k, w1_k, w2_k, pe_v, w1_v, w2_v, w_out, rel_bias):
    B, S, _ = h.shape
    proj = h @ w_in
    cols = []
    off = 0
    for w in IN_SPLITS:
        cols.append(proj[..., off:off + w])
        off += w
    rq, rk, rv, rg, nq_, kc_, vc_, ks_, vs_, kw_, vw_, ngate = cols
    pos = jnp.arange(S, dtype=jnp.int32)
    q_r = rotary(rq.reshape(B, S, RET_HEADS, RET_DK), pos)
    k_r = rotary(rk.reshape(B, S, RET_HEADS, RET_DK), pos) * (RET_DK ** -0.5)
    v_r = rv.reshape(B, S, RET_HEADS, RET_DV).astype(jnp.float32)
    y = retention(q_r, k_r, v_r)
    mu = jnp.mean(y, axis=-1, keepdims=True)
    var = jnp.mean((y - mu) ** 2, axis=-1, keepdims=True)
    y = ((y - mu) * lax.rsqrt(var + EPS)).reshape(B, S, RET_W) * ret_gn_gain.astype(jnp.float32)
    y_ret = (jax.nn.silu(rg.astype(jnp.float32)) * y).astype(h.dtype)
    y_nsa = nsa(nq_.reshape(B, S, NSA_HEADS, NSA_DH), kc_, vc_, ks_, vs_, kw_, vw_, ngate,
                pe_k, w1_k, w2_k, pe_v, w1_v, w2_v, rel_bias)
    return jnp.concatenate([y_ret, y_nsa], axis=-1) @ w_out


def setup_inputs(seed: int = 0) -> dict:
    key = jax.random.key(seed)
    ks = jax.random.split(key, 24)
    f32 = jnp.float32

    def nrm(k, shape, scale):
        return jax.random.normal(k, shape, f32) * scale

    def gain(k, shape):
        return 1.0 + 0.05 * jax.random.normal(k, shape, f32)

    L, dh = CMP_LEN, NSA_DH
    return {
        "x": nrm(ks[0], (BATCH, SEQ, D_MODEL), 1.0),
        "ffn1_norm": gain(ks[1], (DEPTH, D_MODEL)),
        "ffn1_w1": nrm(ks[2], (DEPTH, D_MODEL, D_FF), D_MODEL ** -0.5),
        "ffn1_w3": nrm(ks[3], (DEPTH, D_MODEL, D_FF), D_MODEL ** -0.5),
        "ffn1_w2": nrm(ks[4], (DEPTH, D_FF, D_MODEL), D_FF ** -0.5),
        "mix_norm": gain(ks[5], (DEPTH, D_MODEL)),
        "w_in": nrm(ks[6], (DEPTH, D_MODEL, D_IN), D_MODEL ** -0.5),
        "ret_gn_gain": gain(ks[7], (DEPTH, RET_W)),
        "cmp_pe_k": nrm(ks[8], (DEPTH, L, dh), 0.1),
        "cmp_w1_k": nrm(ks[9], (DEPTH, L, dh, dh), (L * dh) ** -0.5),
        "cmp_w2_k": nrm(ks[10], (DEPTH, dh, dh), dh ** -0.5),
        "cmp_pe_v": nrm(ks[11], (DEPTH, L, dh), 0.1),
        "cmp_w1_v": nrm(ks[12], (DEPTH, L, dh, dh), (L * dh) ** -0.5),
        "cmp_w2_v": nrm(ks[13], (DEPTH, dh, dh), dh ** -0.5),
        "w_out": nrm(ks[14], (DEPTH, D_MIX, D_MODEL), D_MIX ** -0.5),
        "ffn2_norm": gain(ks[15], (DEPTH, D_MODEL)),
        "ffn2_w1": nrm(ks[16], (DEPTH, D_MODEL, D_FF), D_MODEL ** -0.5),
        "ffn2_w3": nrm(ks[17], (DEPTH, D_MODEL, D_FF), D_MODEL ** -0.5),
        "ffn2_w2": nrm(ks[18], (DEPTH, D_FF, D_MODEL), D_FF ** -0.5),
        "rel_bias": nrm(ks[19], (NSA_HEADS, REL_BUCKETS), 0.5),
        "final_norm": gain(ks[20], (D_MODEL,)),
    }


def reference(x, ffn1_norm, ffn1_w1, ffn1_w3, ffn1_w2, mix_norm, w_in, ret_gn_gain,
              cmp_pe_k, cmp_w1_k, cmp_w2_k, cmp_pe_v, cmp_w1_v, cmp_w2_v, w_out,
              ffn2_norm, ffn2_w1, ffn2_w3, ffn2_w2, rel_bias, final_norm):
    for l in range(DEPTH):
        x = x + 0.5 * swiglu(rmsnorm(x, ffn1_norm[l]), ffn1_w1[l], ffn1_w3[l], ffn1_w2[l])
        x = x + token_mix(rmsnorm(x, mix_norm[l]), w_in[l], ret_gn_gain[l],
                          cmp_pe_k[l], cmp_w1_k[l], cmp_w2_k[l],
                          cmp_pe_v[l], cmp_w1_v[l], cmp_w2_v[l], w_out[l], rel_bias)
        x = x + 0.5 * swiglu(rmsnorm(x, ffn2_norm[l]), ffn2_w1[l], ffn2_w3[l], ffn2_w2[l])
    return rmsnorm(x, final_norm)
```

```cpp
#include <hip/hip_runtime.h>
#include <hip/hip_cooperative_groups.h>
#include <cstdio>
#include <cstdint>
namespace cg = cooperative_groups;

#define LAS __attribute__((address_space(3)))
typedef unsigned short bf16_t;
typedef short bf16x8 __attribute__((ext_vector_type(8)));
typedef short bf16x4 __attribute__((ext_vector_type(4)));
typedef float f32x2 __attribute__((ext_vector_type(2)));
typedef float f32x4 __attribute__((ext_vector_type(4)));
typedef float f32x16 __attribute__((ext_vector_type(16)));
typedef unsigned u32x2 __attribute__((ext_vector_type(2)));
typedef unsigned u32x4 __attribute__((ext_vector_type(4)));

constexpr int NTOK = 16384, SEQ = 4096, DM = 2048, DFF = 5632, DIN = 6680;
constexpr int PROJ_LD = 3328;
constexpr int PROJT_ROWS = 512;
constexpr int WIN_NORMAL = 5376;
constexpr int WINT_ROWS = 6912;
constexpr int PC_RG = 0, PC_NQ = 1024, PC_KC = 2048, PC_VC = 2304, PC_KS = 2560, PC_KW = 2816, PC_GATE = 3072;
constexpr int PT_VS = 0, PT_VW = 256;

constexpr size_t WS_W13T = 16384;
constexpr size_t WS_W2T = WS_W13T + (size_t)11264 * 2048 * 2;
constexpr size_t WS_WINT = WS_W2T + (size_t)2048 * 5632 * 2;
constexpr size_t WS_WOUTT = WS_WINT + (size_t)WINT_ROWS * 2048 * 2;
constexpr size_t WS_CW1KT = WS_WOUTT + (size_t)2048 * 2048 * 2;
constexpr size_t WS_CW1VT = WS_CW1KT + (size_t)128 * 4096 * 2;
constexpr size_t WS_CW2KT = WS_CW1VT + (size_t)128 * 4096 * 2;
constexpr size_t WS_CW2VT = WS_CW2KT + (size_t)128 * 128 * 2;
constexpr size_t WS_CVEC = WS_CW2VT + (size_t)128 * 128 * 2;
constexpr size_t WS_ROT = WS_CVEC + 4096;
constexpr size_t WS_ROTT = WS_ROT + (size_t)2 * 4096 * 128 * 4;
constexpr size_t WS_XN = WS_ROTT + (size_t)2 * 4096 * 128 * 4;
constexpr size_t WS_BIG = WS_XN + (size_t)NTOK * DM * 2;
constexpr size_t WS_PROJT = WS_BIG + (size_t)NTOK * PROJ_LD * 2;
constexpr size_t WS_KSF = WS_PROJT;
constexpr size_t WS_KWF = WS_KSF + (size_t)8 * 64 * 16384;
constexpr size_t WS_VSF = WS_KWF + (size_t)8 * 64 * 16384;
constexpr size_t WS_VWF = WS_VSF + (size_t)8 * 64 * 16384;
constexpr size_t WS_QF = WS_VWF + (size_t)8 * 64 * 16384;
constexpr size_t WS_KF = WS_QF + (size_t)NTOK * 1024 * 2;
constexpr size_t WS_KTF = WS_KF + (size_t)NTOK * 1024 * 2;
constexpr size_t WS_VTF = WS_KTF + (size_t)NTOK * 1024 * 2;
constexpr size_t WS_UT = WS_VTF + (size_t)NTOK * 1024 * 2;
constexpr size_t WS_KCMP = WS_UT + (size_t)512 * 65536 * 2;
constexpr size_t WS_VCMPT = WS_KCMP + (size_t)8 * 256 * 128 * 2;
constexpr size_t WS_SSQ = WS_VCMPT + (size_t)8 * 256 * 128 * 2;
constexpr size_t WS_END = WS_SSQ + (size_t)3 * NTOK * 4;
static_assert(WS_BIG + (size_t)NTOK * DFF * 2 <= WS_UT, "ACT overlays PROJ/PROJT");

typedef __bf16 bf16x2_t __attribute__((ext_vector_type(2)));
__device__ __forceinline__ unsigned cvt_pk_bf16(float lo, float hi) { const f32x2 v = {lo, hi}; return __builtin_bit_cast(unsigned, __builtin_convertvector(v, bf16x2_t)); }
__device__ __forceinline__ int opaque_i(int v) { asm volatile("" : "+v"(v)); return v; }
__device__ __forceinline__ float bf2f(unsigned short h) { return __builtin_bit_cast(float, (unsigned)h << 16); }
__device__ __forceinline__ float bflo(unsigned u) { return __builtin_bit_cast(float, u << 16); }
__device__ __forceinline__ float bfhi(unsigned u) { return __builtin_bit_cast(float, u & 0xffff0000u); }
__device__ __forceinline__ float fast_rcp(float x) { return __builtin_amdgcn_rcpf(x); }
__device__ __forceinline__ float silu_f(float v) { return v * fast_rcp(1.0f + __expf(-v)); }
__device__ __forceinline__ float sigmoid_f(float v) { return fast_rcp(1.0f + __expf(-v)); }

namespace pg8 {
constexpr int BM = 256, BK = 64, HALF = 128, HTB = HALF * BK * 2, STAGE_BYTES = 8 * HTB, NXCD = 8, WGM = 2;
__host__ __device__ __forceinline__ int lds_byte(int r, int c) { const int st = (r >> 4) * 2 + (c >> 5), rr = r & 15, cc = c & 31, ob = rr * 64 + cc * 2; return st * 1024 + (ob ^ (((ob >> 9) & 1) << 5)); }
__host__ __device__ __forceinline__ void stage_rc(int b, int& R, int& C) { const int st = b / 1024, sb = b % 1024, swz = sb ^ (((sb >> 9) & 1) << 5); R = (st >> 1) * 16 + swz / 64; C = (st & 1) * 32 + (swz % 64) / 2; }
__host__ __device__ __forceinline__ int perm32(int rho) { const int n = rho >> 4, i = rho & 15; return 8 * (i >> 2) + 4 * n + (i & 3); }

struct Unit { int pm, pn, kind; };
__device__ __forceinline__ void map_unit(int wgid, int nM, int nN, int& pm, int& pn) {
    const int nwg = nM * nN;
    { const int q = nwg / NXCD, r = nwg % NXCD, xcd = wgid % NXCD, off = wgid / NXCD; wgid = (xcd < r ? xcd * (q + 1) : r * (q + 1) + (xcd - r) * q) + off; }
    const int nig = WGM * nN, gid = wgid / nig, fm = gid * WGM, gsz = (nM - fm) < WGM ? (nM - fm) : WGM;
    pm = fm + ((wgid % nig) % gsz); pn = (wgid % nig) / gsz;
}
struct StaticOrder {
    const char* A; const char* Bt; int nM, nN, nwg, G, c; size_t tstep;
    __device__ void init(const void* A_, const void* Bt_, int M, int N, int K, int G_, int c_) { A = (const char*)A_; Bt = (const char*)Bt_; nM = M / BM; nN = N / BM; nwg = nM * nN; G = G_; c = c_; tstep = (size_t)BM * K * 2; }
    __device__ __forceinline__ bool next(int i, Unit& u) const { const int L = i * G + c; if (L >= nwg) return false; map_unit(L, nM, nN, u.pm, u.pn); u.kind = 0; return true; }
    __device__ __forceinline__ void ptrs(const Unit& u, const char*& a, const char*& b) const { a = A + (size_t)u.pm * tstep; b = Bt + (size_t)u.pn * tstep; }
};

template <class Epi, class Sched>
__device__ __forceinline__ void gemm_phase(LAS unsigned char* lds, const int K, const Sched& S, const Epi& E) {
    const int tid = threadIdx.x, wid = __builtin_amdgcn_readfirstlane(tid >> 6), lane = tid & 63, wr = wid >> 2, wc = wid & 3, fr = lane & 15, fq = lane >> 4;
    const int nt = K / BK;
    unsigned voffA[2], voffB[2];
#pragma unroll
    for (int i = 0; i < 2; ++i) { int R, C; stage_rc(tid * 16 + i * 8192, R, C); const int Rb = (R & ~31) + perm32(R & 31);
        voffA[i] = (unsigned)(R * K + C) * 2u; voffB[i] = (unsigned)(Rb * K + C) * 2u; }
    const size_t kstep = (size_t)(BK * 2);
    const size_t hstep = (size_t)HALF * K * 2;
    const unsigned ldsw = (unsigned)wid * 1024u;
    const int aoff = lds_byte(wr * 64 + fr, fq * 8), boff = lds_byte(wc * 32 + fr, fq * 8);
#define PG8_SA(b, h) (((b) * 2 + (h)) * HTB)
#define PG8_SB(b, h) ((4 + (b) * 2 + (h)) * HTB)
#define PG8_STAGE(bufoff, gbase, voff) do { _Pragma("unroll") for (int _i = 0; _i < 2; ++_i) \
        __builtin_amdgcn_global_load_lds((const unsigned*)((const char*)(gbase) + (voff)[_i]), (LAS unsigned*)(lds + (bufoff) + ldsw + _i * 8192), 16, 0, 0); } while (0)
#define PG8_LDA(dst, b, h) do { _Pragma("unroll") for (int m = 0; m < 4; ++m) _Pragma("unroll") for (int k = 0; k < 2; ++k) dst[m][k] = *(const LAS bf16x8*)(lds + PG8_SA(b, h) + aoff + m * 2048 + k * 1024); } while (0)
#define PG8_LDB(dst, b, h) do { _Pragma("unroll") for (int n = 0; n < 2; ++n) _Pragma("unroll") for (int k = 0; k < 2; ++k) dst[n][k] = *(const LAS bf16x8*)(lds + PG8_SB(b, h) + boff + n * 2048 + k * 1024); } while (0)
#define PG8_MMA(ai, bj, At, Bt) do { __builtin_amdgcn_s_setprio(1); _Pragma("unroll") for (int m = 0; m < 4; ++m) _Pragma("unroll") for (int n = 0; n < 2; ++n) _Pragma("unroll") for (int k = 0; k < 2; ++k) \
        acc[ai][bj][m][n] = __builtin_amdgcn_mfma_f32_16x16x32_bf16(Bt[n][k], At[m][k], acc[ai][bj][m][n], 0, 0, 0); __builtin_amdgcn_s_setprio(0); } while (0)
#define PG8_WAIT_V(n) asm volatile("s_waitcnt vmcnt(" #n ")" ::: "memory")
#define PG8_WAIT_L(n) asm volatile("s_waitcnt lgkmcnt(" #n ")" ::: "memory")
#define PG8_BAR __builtin_amdgcn_s_barrier()
#define PG8_SCHED __builtin_amdgcn_sched_barrier(0)
    Unit cur, nxt; int ui = 0;
    if (!S.next(0, cur)) return;
    f32x4 acc[2][2][4][2];
#pragma unroll
    for (int a = 0; a < 2; ++a)
#pragma unroll
        for (int b = 0; b < 2; ++b)
#pragma unroll
            for (int m = 0; m < 4; ++m)
#pragma unroll
                for (int n = 0; n < 2; ++n) acc[a][b][m][n] = (f32x4){0.f, 0.f, 0.f, 0.f};
    bf16x8 At[4][2], B0[2][2], B1[2][2];
    const char* cA; const char* cB; S.ptrs(cur, cA, cB);
    PG8_STAGE(PG8_SB(0, 0), cB, voffB); PG8_STAGE(PG8_SB(0, 1), cB + hstep, voffB); PG8_STAGE(PG8_SA(0, 0), cA, voffA); PG8_STAGE(PG8_SA(0, 1), cA + hstep, voffA);
    if (wr == 1) PG8_BAR;
    PG8_WAIT_V(2); PG8_BAR;
    PG8_STAGE(PG8_SB(1, 0), cB + kstep, voffB); PG8_STAGE(PG8_SA(1, 0), cA + kstep, voffA); PG8_STAGE(PG8_SB(1, 1), cB + hstep + kstep, voffB);
    PG8_WAIT_V(6); PG8_BAR;
    for (;;) {
        const bool has_next = S.next(ui + 1, nxt);
        const char* nA = cA; const char* nB = cB; if (has_next) S.ptrs(nxt, nA, nB);
        for (int t = 0; t < nt; t += 2) {
            const bool last = (t == nt - 2);
            const char* a1 = cA + (size_t)(t + 1) * kstep;
            const char* a2 = last ? nA : cA + (size_t)(t + 2) * kstep; const char* b2 = last ? nB : cB + (size_t)(t + 2) * kstep;
            const char* a3 = a2 + kstep; const char* b3 = b2 + kstep;
            PG8_LDB(B0, 0, 0); PG8_LDB(B1, 0, 1); PG8_SCHED; PG8_LDA(At, 0, 0); PG8_STAGE(PG8_SA(1, 1), a1 + hstep, voffA);
            PG8_WAIT_V(8); PG8_WAIT_L(0); PG8_BAR; PG8_MMA(0, 0, At, B0); PG8_MMA(0, 1, At, B1); PG8_BAR; PG8_SCHED;
            PG8_LDA(At, 0, 1); PG8_STAGE(PG8_SB(0, 0), b2, voffB); PG8_STAGE(PG8_SB(0, 1), b2 + hstep, voffB); PG8_STAGE(PG8_SA(0, 0), a2, voffA);
            PG8_WAIT_V(8); PG8_WAIT_L(0); PG8_BAR; PG8_MMA(1, 0, At, B0); PG8_MMA(1, 1, At, B1); PG8_BAR; PG8_SCHED;
            PG8_LDB(B0, 1, 0); PG8_LDB(B1, 1, 1); PG8_SCHED; PG8_LDA(At, 1, 0); PG8_STAGE(PG8_SA(0, 1), a2 + hstep, voffA);
            PG8_WAIT_V(8); PG8_WAIT_L(0); PG8_BAR; PG8_MMA(0, 0, At, B0); PG8_MMA(0, 1, At, B1); PG8_BAR; PG8_SCHED;
            PG8_LDA(At, 1, 1); PG8_STAGE(PG8_SB(1, 0), b3, voffB); PG8_STAGE(PG8_SB(1, 1), b3 + hstep, voffB); PG8_STAGE(PG8_SA(1, 0), a3, voffA);
            PG8_WAIT_V(8); PG8_WAIT_L(0); PG8_BAR; PG8_MMA(1, 0, At, B0); PG8_MMA(1, 1, At, B1); PG8_BAR; PG8_SCHED;
        }
        if (wr == 0) PG8_BAR;
        E(acc, cur, wr, wc, fr, fq);
        if (!has_next) break;
#pragma unroll
        for (int a = 0; a < 2; ++a)
#pragma unroll
            for (int b = 0; b < 2; ++b)
#pragma unroll
                for (int m = 0; m < 4; ++m)
#pragma unroll
                    for (int n = 0; n < 2; ++n) acc[a][b][m][n] = (f32x4){0.f, 0.f, 0.f, 0.f};
        cur = nxt; cA = nA; cB = nB; ++ui;
        if (wr == 1) PG8_BAR;
    }
    PG8_WAIT_V(0);
    PG8_BAR;
#undef PG8_SA
#undef PG8_SB
#undef PG8_STAGE
#undef PG8_LDA
#undef PG8_LDB
#undef PG8_MMA
#undef PG8_WAIT_V
#undef PG8_WAIT_L
#undef PG8_BAR
#undef PG8_SCHED
}
}

using pg8::Unit;
struct EpiSwiglu {
    bf16_t* O; int ldc; const float* ssq;
    __device__ __forceinline__ void operator()(const f32x4 (&acc)[2][2][4][2], const Unit& u, int wr, int wc, int fr, int fq) const {
        const int row0 = u.pm * 256 + wr * 64 + fr, col0 = u.pn * 128 + wc * 32 + 8 * fq;
#pragma unroll
        for (int ai = 0; ai < 2; ++ai)
#pragma unroll
            for (int m = 0; m < 4; ++m) {
                bf16_t* rowp = O + (size_t)(row0 + ai * 128 + m * 16) * ldc + col0;
                const float rs = ssq ? rsqrtf(ssq[row0 + ai * 128 + m * 16] * (1.0f / DM) + 1e-6f) : 1.0f;
                float v[8];
#pragma unroll
                for (int n = 0; n < 2; ++n)
#pragma unroll
                    for (int j = 0; j < 4; ++j) v[n * 4 + j] = silu_f(acc[ai][0][m][n][j] * rs) * (acc[ai][1][m][n][j] * rs);
                u32x4 w; w.x = cvt_pk_bf16(v[0], v[1]); w.y = cvt_pk_bf16(v[2], v[3]); w.z = cvt_pk_bf16(v[4], v[5]); w.w = cvt_pk_bf16(v[6], v[7]);
                *(u32x4*)rowp = w;
            }
    }
};
struct EpiResid {
    const float* R; const bf16_t* Rb; float scale; bf16_t* Xb; float* ssq;
    __device__ __forceinline__ void operator()(const f32x4 (&acc)[2][2][4][2], const Unit& u, int wr, int wc, int fr_, int fq_) const {
        const int fr = opaque_i(fr_), fq = opaque_i(fq_);
        const int row0 = u.pm * 256 + wr * 64 + fr, col0 = u.pn * 256 + wc * 32 + 8 * fq;
#pragma unroll
        for (int ai = 0; ai < 2; ++ai)
#pragma unroll
            for (int m = 0; m < 4; ++m) {
                const int row = row0 + ai * 128 + m * 16; float sq = 0.f;
#pragma unroll
                for (int bj = 0; bj < 2; ++bj) {
                    const size_t off = (size_t)row * DM + col0 + bj * 128;
                    f32x4 r0, r1;
                    if (R) { r0 = *(const f32x4*)(R + off); r1 = *(const f32x4*)(R + off + 4); }
                    else { const u32x4 rb = *(const u32x4*)(Rb + off); r0 = (f32x4){bflo(rb.x), bfhi(rb.x), bflo(rb.y), bfhi(rb.y)}; r1 = (f32x4){bflo(rb.z), bfhi(rb.z), bflo(rb.w), bfhi(rb.w)}; }
                    const f32x4 o0 = r0 + acc[ai][bj][m][0] * scale, o1 = r1 + acc[ai][bj][m][1] * scale;
                    sq += o0[0] * o0[0] + o0[1] * o0[1] + o0[2] * o0[2] + o0[3] * o0[3] + o1[0] * o1[0] + o1[1] * o1[1] + o1[2] * o1[2] + o1[3] * o1[3];
                    u32x4 w; w.x = cvt_pk_bf16(o0[0], o0[1]); w.y = cvt_pk_bf16(o0[2], o0[3]); w.z = cvt_pk_bf16(o1[0], o1[1]); w.w = cvt_pk_bf16(o1[2], o1[3]);
                    *(u32x4*)(Xb + off) = w;
                }
                sq += __shfl_xor(sq, 16); sq += __shfl_xor(sq, 32); if (fq == 0) atomicAdd(ssq + row, sq);
            }
    }
};
struct EpiProj {
    unsigned char* ws;
    __device__ __forceinline__ void operator()(const f32x4 (&acc)[2][2][4][2], const Unit& u, int wr, int wc, int fr_, int fq_) const {
        const int fr = opaque_i(fr_), fq = opaque_i(fq_);
        bf16_t* const P = (bf16_t*)(ws + WS_BIG); bf16_t* const KSF = (bf16_t*)(ws + WS_KSF); bf16_t* const KWF = (bf16_t*)(ws + WS_KWF); bf16_t* const VSF = (bf16_t*)(ws + WS_VSF); bf16_t* const VWF = (bf16_t*)(ws + WS_VWF);
        bf16_t* const QF = (bf16_t*)(ws + WS_QF); bf16_t* const KF = (bf16_t*)(ws + WS_KF); bf16_t* const KTF = (bf16_t*)(ws + WS_KTF); bf16_t* const VTF = (bf16_t*)(ws + WS_VTF);
        const float* const rot = (const float*)(ws + WS_ROT); const float* const rott = (const float*)(ws + WS_ROTT); const float* const ssq = (const float*)(ws + WS_SSQ);
        if (u.kind == 0) {
            const int row0 = u.pm * 256 + wr * 64 + fr;
            if (u.pn < 8) {
                const float sc0 = (u.pn >= 4) ? 0.0625f : 1.0f; bf16_t* dst = (u.pn >= 4) ? KF : QF; const int h = u.pn & 3;
#pragma unroll
                for (int ai = 0; ai < 2; ++ai) {
                    f32x4 cc[4][2], ss[4][2]; float scv[4];
#pragma unroll
                    for (int m = 0; m < 4; ++m) {
                        const int row = row0 + ai * 128 + m * 16; const int pos = row & (SEQ - 1);
                        scv[m] = ssq[row];
#pragma unroll
                        for (int n = 0; n < 2; ++n) { const int dd = wc * 32 + 8 * fq + 4 * n;
                            cc[m][n] = *(const f32x4*)(rot + (size_t)pos * 128 + dd); ss[m][n] = *(const f32x4*)(rot + (size_t)SEQ * 128 + (size_t)pos * 128 + dd); }
                    }
                    __builtin_amdgcn_sched_barrier(0);
#pragma unroll
                    for (int m = 0; m < 4; ++m) {
                        const int row = row0 + ai * 128 + m * 16; const int pos = row & (SEQ - 1), b = row >> 12;
                        const float sc = sc0 * rsqrtf(scv[m] * (1.0f / DM) + 1e-6f);
                        f32x4 o[2][2];
#pragma unroll
                        for (int n = 0; n < 2; ++n) {
                            const f32x4 x1 = acc[ai][0][m][n], x2 = acc[ai][1][m][n];
                            o[0][n] = (x1 * cc[m][n] - x2 * ss[m][n]) * sc; o[1][n] = (x1 * ss[m][n] + x2 * cc[m][n]) * sc;
                        }
#pragma unroll
                        for (int bj = 0; bj < 2; ++bj) {
                            u32x4 w; w.x = cvt_pk_bf16(o[bj][0][0], o[bj][0][1]); w.y = cvt_pk_bf16(o[bj][0][2], o[bj][0][3]); w.z = cvt_pk_bf16(o[bj][1][0], o[bj][1][1]); w.w = cvt_pk_bf16(o[bj][1][2], o[bj][1][3]);
                            const int ks = 8 * bj + 2 * wc + (fq >> 1), hi = fq & 1;
                            *(u32x4*)(dst + ((((size_t)(b * 4 + h) * 128 + (pos >> 5)) * 16 + ks) * 64 + hi * 32 + (pos & 31)) * 8) = w;
                        }
                    }
                }
            } else if (u.pn == 18 || u.pn == 19) {
                bf16_t* dst = (u.pn == 18) ? KSF : KWF;
#pragma unroll
                for (int ai = 0; ai < 2; ++ai)
#pragma unroll
                    for (int m = 0; m < 4; ++m) {
                        const int row = row0 + ai * 128 + m * 16; const int pos = row & (SEQ - 1), b = row >> 12;
                        const float rs = rsqrtf(ssq[row] * (1.0f / DM) + 1e-6f);
#pragma unroll
                        for (int bj = 0; bj < 2; ++bj) {
                            const f32x4 v0 = acc[ai][bj][m][0] * rs, v1 = acc[ai][bj][m][1] * rs;
                            u32x4 w; w.x = cvt_pk_bf16(v0[0], v0[1]); w.y = cvt_pk_bf16(v0[2], v0[3]); w.z = cvt_pk_bf16(v1[0], v1[1]); w.w = cvt_pk_bf16(v1[2], v1[3]);
                            const int ks = 2 * wc + (fq >> 1);
                            *(u32x4*)(dst + (((((size_t)(b * 2 + bj) * 64 + (pos >> 6)) * 2 + ((pos >> 5) & 1)) * 8 + ks) * 64 + (fq & 1) * 32 + (pos & 31)) * 8) = w;
                        }
                    }
            } else {
                const int col0 = (u.pn - 8) * 256 + wc * 32 + 8 * fq;
#pragma unroll
                for (int ai = 0; ai < 2; ++ai)
#pragma unroll
                    for (int m = 0; m < 4; ++m) {
                        const int row = row0 + ai * 128 + m * 16;
                        const float rs = rsqrtf(ssq[row] * (1.0f / DM) + 1e-6f);
#pragma unroll
                        for (int bj = 0; bj < 2; ++bj) {
                            const f32x4 v0 = acc[ai][bj][m][0] * rs, v1 = acc[ai][bj][m][1] * rs;
                            u32x4 w; w.x = cvt_pk_bf16(v0[0], v0[1]); w.y = cvt_pk_bf16(v0[2], v0[3]); w.z = cvt_pk_bf16(v1[0], v1[1]); w.w = cvt_pk_bf16(v1[2], v1[3]);
                            *(u32x4*)(P + (size_t)row * PROJ_LD + col0 + bj * 128) = w;
                        }
                    }
            }
        } else {
            if (u.pm == 4 || u.pm == 5) {
                bf16_t* dst = (u.pm == 4) ? VSF : VWF; const int b = u.pn >> 4;
#pragma unroll
                for (int ai = 0; ai < 2; ++ai)
#pragma unroll
                    for (int m = 0; m < 4; ++m)
#pragma unroll
                        for (int bj = 0; bj < 2; ++bj) {
                            const int tj = 4 * (u.pn & 15) + 2 * bj + (wc >> 1), dt = 2 * wr + (m >> 1), r32 = 16 * (m & 1) + fr, st = 2 * (wc & 1) + (fq >> 1);
                            bf16_t* fp = dst + (((((size_t)(b * 2 + ai) * 64 + tj) * 4 + dt) * 4 + st) * 64 + r32) * 8 + 4 * (fq & 1);
#pragma unroll
                            for (int n = 0; n < 2; ++n) { const f32x4 q4 = *(const f32x4*)(ssq + u.pn * 256 + bj * 128 + wc * 32 + 8 * fq + 4 * n) * (1.0f / DM) + 1e-6f;
                                const f32x4 v = acc[ai][bj][m][n] * (f32x4){rsqrtf(q4[0]), rsqrtf(q4[1]), rsqrtf(q4[2]), rsqrtf(q4[3])}; u32x2 w; w.x = cvt_pk_bf16(v[0], v[1]); w.y = cvt_pk_bf16(v[2], v[3]); *(u32x2*)(fp + n * 32 * 8) = w; }
                        }
            } else {
                const bool rotate = u.pm >= 6; const int h = rotate ? u.pm - 6 : u.pm; bf16_t* dst = rotate ? KTF : VTF;
                const int b = u.pn >> 4;
#pragma unroll
                for (int m = 0; m < 4; ++m) {
                    const int dd = wr * 64 + m * 16 + fr;
#pragma unroll
                    for (int bj = 0; bj < 2; ++bj) {
                        const int chunk = 2 * (u.pn & 15) + bj;
                        f32x4 o[2][2]; f32x4 qv[2], cv[2], sv[2];
#pragma unroll
                        for (int n = 0; n < 2; ++n) {
                            const int pos = chunk * 128 + wc * 32 + 8 * fq + 4 * n;
                            qv[n] = *(const f32x4*)(ssq + u.pn * 256 + bj * 128 + wc * 32 + 8 * fq + 4 * n);
                            if (rotate) { cv[n] = *(const f32x4*)(rott + (size_t)dd * SEQ + pos); sv[n] = *(const f32x4*)(rott + (size_t)128 * SEQ + (size_t)dd * SEQ + pos); }
                        }
                        __builtin_amdgcn_sched_barrier(0);
#pragma unroll
                        for (int n = 0; n < 2; ++n) {
                            const f32x4 q4 = qv[n] * (1.0f / DM) + 1e-6f;
                            const f32x4 rs4 = (f32x4){rsqrtf(q4[0]), rsqrtf(q4[1]), rsqrtf(q4[2]), rsqrtf(q4[3])};
                            if (rotate) {
                                const f32x4 x1 = acc[0][bj][m][n] * rs4, x2 = acc[1][bj][m][n] * rs4;
                                o[0][n] = (x1 * cv[n] - x2 * sv[n]) * 0.0625f; o[1][n] = (x1 * sv[n] + x2 * cv[n]) * 0.0625f;
                            } else { o[0][n] = acc[0][bj][m][n] * rs4; o[1][n] = acc[1][bj][m][n] * rs4; }
                        }
#pragma unroll
                        for (int ai = 0; ai < 2; ++ai) {
                            const int rtile = 4 * ai + 2 * wr + (m >> 1), r32 = 16 * (m & 1) + fr, st = 2 * wc + (fq >> 1);
                            bf16_t* fp = dst + (((((size_t)(b * 4 + h) * 32 + chunk) * 8 + rtile) * 8 + st) * 64 + r32) * 8 + 4 * (fq & 1);
#pragma unroll
                            for (int n = 0; n < 2; ++n) { u32x2 w; w.x = cvt_pk_bf16(o[ai][n][0], o[ai][n][1]); w.y = cvt_pk_bf16(o[ai][n][2], o[ai][n][3]); *(u32x2*)(fp + n * 32 * 8) = w; }
                        }
                    }
                }
            }
        }
    }
};
struct WinOrder {
    const char* XN; const char* WT; int G, c; size_t tstep;
    __device__ __forceinline__ bool next(int i, Unit& u) const {
        const int L = i * G + c;
        if (L < 64 * 21) { pg8::map_unit(L, 64, 21, u.pm, u.pn); u.kind = 0; return true; }
        if (L < 64 * 21 + 384) { pg8::map_unit(L - 64 * 21, 6, 64, u.pm, u.pn); u.kind = 1; return true; }
        return false;
    }
    __device__ __forceinline__ void ptrs(const Unit& u, const char*& a, const char*& b) const {
        if (u.kind == 0) { a = XN + (size_t)u.pm * tstep; b = WT + (size_t)u.pn * tstep; }
        else { const int wrow = u.pm < 6 ? (WIN_NORMAL / 256 + u.pm) : (4 + (u.pm - 6)); a = WT + (size_t)wrow * tstep; b = XN + (size_t)u.pn * tstep; }
    }
};

__device__ __forceinline__ float wave_sum(float v) {
#pragma unroll
    for (int o = 32; o >= 1; o >>= 1) v += __shfl_xor(v, o);
    return v;
}
__device__ __forceinline__ int winmap(int n0) {
    if (n0 < 1024) return n0;
    if (n0 < 2048) return n0;
    if (n0 < 3072) return WIN_NORMAL + (n0 - 2048);
    if (n0 < 4096) return 2048 + PC_RG + (n0 - 3072);
    if (n0 < 5120) return 2048 + PC_NQ + (n0 - 4096);
    if (n0 < 5376) return 2048 + PC_KC + (n0 - 5120);
    if (n0 < 5632) return 2048 + PC_VC + (n0 - 5376);
    if (n0 < 5888) return 2048 + PC_KS + (n0 - 5632);
    if (n0 < 6144) return WIN_NORMAL + 1024 + (n0 - 5888);
    if (n0 < 6400) return 2048 + PC_KW + (n0 - 6144);
    if (n0 < 6656) return WIN_NORMAL + 1280 + (n0 - 6400);
    return 2048 + PC_GATE + (n0 - 6656);
}
__device__ __forceinline__ int drow_of(int kind, int n) {
    if (kind == 0) return n;
    if (kind == 1) return 256 * (n >> 7) + (n & 127);
    if (kind == 2) return 256 * (n >> 7) + 128 + (n & 127);
    return winmap(n & ~63) + (n & 63);
}
struct WItem { const float* src; bf16_t* dst; const float* gk; int ld, ncols, k0, n0, Kd, kind; };
__device__ __forceinline__ void wconv_load(const WItem& t, f32x4 (&v)[8]) {
    const int tid = threadIdx.x;
#pragma unroll
    for (int i = 0; i < 8; ++i) {
        const int idx = tid + i * 512, kk = idx >> 6, c4 = (idx & 63) * 4;
        v[i] = (f32x4){0.f, 0.f, 0.f, 0.f};
        if (t.n0 + c4 + 3 < t.ncols) v[i] = *(const f32x4*)(t.src + (size_t)(t.k0 + kk) * t.ld + t.n0 + c4);
        if (t.gk) v[i] = v[i] * t.gk[t.k0 + kk];
    }
}
__device__ __forceinline__ void wconv_commit(const f32x4 (&v)[8], LAS float* tile) {
    const int tid = threadIdx.x;
#pragma unroll
    for (int i = 0; i < 8; ++i) {
        const int idx = tid + i * 512, kk = idx >> 6, c4 = (idx & 63) * 4;
        tile[kk * 257 + c4 + 0] = v[i][0]; tile[kk * 257 + c4 + 1] = v[i][1]; tile[kk * 257 + c4 + 2] = v[i][2]; tile[kk * 257 + c4 + 3] = v[i][3];
    }
}
__device__ __forceinline__ void wconv_drain(const WItem& t, LAS float* tile) {
    const int tid = threadIdx.x;
#pragma unroll
    for (int j = 0; j < 4; ++j) {
        const int n = (tid >> 3) + 64 * j, kc = (tid & 7) * 8;
        if (t.n0 + n < t.ncols) {
            float x[8];
#pragma unroll
            for (int q = 0; q < 8; ++q) x[q] = tile[(kc + q) * 257 + n];
            u32x4 w; w.x = cvt_pk_bf16(x[0], x[1]); w.y = cvt_pk_bf16(x[2], x[3]); w.z = cvt_pk_bf16(x[4], x[5]); w.w = cvt_pk_bf16(x[6], x[7]);
            if (t.kind == 4) { const int k = t.k0 + kc; *(u32x4*)(t.dst + ((((size_t)(n >> 5) * 256 + (k >> 4)) * 64 + ((k >> 3) & 1) * 32 + (n & 31)) * 8)) = w; }
            else *(u32x4*)(t.dst + (size_t)drow_of(t.kind, t.n0 + n) * t.Kd + t.k0 + kc) = w;
        }
    }
}
__device__ __forceinline__ WItem ffn_witem(int it, const float* w1, const float* w3, const float* w2, unsigned char* ws, const float* g13) {
    WItem t; t.gk = nullptr;
    if (it < 1408) { const bool is3 = it >= 704; const int r = is3 ? it - 704 : it; const int kt = r / 22, nt = r % 22;
        t.gk = g13; t.src = is3 ? w3 : w1; t.dst = (bf16_t*)(ws + WS_W13T); t.ld = DFF; t.ncols = DFF; t.k0 = kt * 64; t.n0 = nt * 256; t.Kd = DM; t.kind = is3 ? 2 : 1; }
    else { const int r = it - 1408, kt = r >> 3, nt = r & 7;
        t.src = w2; t.dst = (bf16_t*)(ws + WS_W2T); t.ld = DM; t.ncols = DM; t.k0 = kt * 64; t.n0 = nt * 256; t.Kd = DFF; t.kind = 0; }
    return t;
}
__device__ __forceinline__ WItem p0_witem(int it, const float* const* in, unsigned char* ws) {
    if (it < 2112) return ffn_witem(it, in[2], in[3], in[4], ws, nullptr);
    WItem t; t.kind = 0; t.gk = nullptr;
    if (it < 2976) { const int r = it - 2112, kt = r / 27, nt = r % 27; t.gk = in[5]; t.src = in[6]; t.dst = (bf16_t*)(ws + WS_WINT); t.ld = DIN; t.ncols = DIN; t.k0 = kt * 64; t.n0 = nt * 256; t.Kd = DM; t.kind = 3; }
    else if (it < 3232) { const int r = it - 2976, kt = r >> 3, nt = r & 7; t.src = in[14]; t.dst = (bf16_t*)(ws + WS_WOUTT); t.ld = DM; t.ncols = DM; t.k0 = kt * 64; t.n0 = nt * 256; t.Kd = DM; }
    else if (it < 3296) { const int r = it - 3232; t.src = in[9]; t.dst = (bf16_t*)(ws + WS_CW1KT); t.ld = 128; t.ncols = 128; t.k0 = r * 64; t.n0 = 0; t.Kd = 4096; t.kind = 4; }
    else if (it < 3360) { const int r = it - 3296; t.src = in[12]; t.dst = (bf16_t*)(ws + WS_CW1VT); t.ld = 128; t.ncols = 128; t.k0 = r * 64; t.n0 = 0; t.Kd = 4096; t.kind = 4; }
    else if (it < 3362) { const int r = it - 3360; t.src = in[10]; t.dst = (bf16_t*)(ws + WS_CW2KT); t.ld = 128; t.ncols = 128; t.k0 = r * 64; t.n0 = 0; t.Kd = 128; }
    else { const int r = it - 3362; t.src = in[13]; t.dst = (bf16_t*)(ws + WS_CW2VT); t.ld = 128; t.ncols = 128; t.k0 = r * 64; t.n0 = 0; t.Kd = 128; }
    return t;
}
__device__ __forceinline__ void rms_rows_bf16(const float* __restrict__ X, const float* __restrict__ g, bf16_t* __restrict__ out) {
    const int tx = opaque_i(threadIdx.x); const int lane = tx & 63, gw = blockIdx.x * 8 + (tx >> 6), nw = gridDim.x * 8;
    for (int row = gw; row < NTOK; row += nw) {
        const float* xr = X + (size_t)row * DM; f32x4 v[8]; float ss = 0.f;
#pragma unroll
        for (int i = 0; i < 8; ++i) { v[i] = *(const f32x4*)(xr + (i * 64 + lane) * 4); ss += v[i][0] * v[i][0] + v[i][1] * v[i][1] + v[i][2] * v[i][2] + v[i][3] * v[i][3]; }
        ss = wave_sum(ss); const float rs = rsqrtf(ss * (1.0f / DM) + 1e-6f);
#pragma unroll
        for (int i = 0; i < 8; ++i) { const f32x4 gg = *(const f32x4*)(g + (i * 64 + lane) * 4); const f32x4 y = v[i] * rs * gg;
            u32x2 w; w.x = cvt_pk_bf16(y[0], y[1]); w.y = cvt_pk_bf16(y[2], y[3]); *(u32x2*)(out + (size_t)row * DM + (i * 64 + lane) * 4) = w; }
    }
}
__device__ __forceinline__ void rms_final_from_bf16(const bf16_t* __restrict__ X, const float* __restrict__ ssq, const float* __restrict__ g, float* __restrict__ out) {
    const int tx = opaque_i(threadIdx.x); const int lane = tx & 63, gw = blockIdx.x * 8 + (tx >> 6), nw = gridDim.x * 8;
    for (int row = gw; row < NTOK; row += nw) {
        const float rs = rsqrtf(ssq[row] * (1.0f / DM) + 1e-6f);
#pragma unroll
        for (int i = 0; i < 4; ++i) {
            const int c = (i * 64 + lane) * 8;
            const u32x4 v = *(const u32x4*)(X + (size_t)row * DM + c);
            const f32x4 g0 = *(const f32x4*)(g + c), g1 = *(const f32x4*)(g + c + 4);
            f32x4 o0, o1;
            o0[0] = bflo(v.x) * rs * g0[0]; o0[1] = bfhi(v.x) * rs * g0[1]; o0[2] = bflo(v.y) * rs * g0[2]; o0[3] = bfhi(v.y) * rs * g0[3];
            o1[0] = bflo(v.z) * rs * g1[0]; o1[1] = bfhi(v.z) * rs * g1[1]; o1[2] = bflo(v.w) * rs * g1[2]; o1[3] = bfhi(v.w) * rs * g1[3];
            *(f32x4*)(out + (size_t)row * DM + c) = o0; *(f32x4*)(out + (size_t)row * DM + c + 4) = o1;
        }
    }
}
__device__ __forceinline__ void rms_rows_f32_inplace(float* __restrict__ X, const float* __restrict__ g) {
    const int tx = opaque_i(threadIdx.x); const int lane = tx & 63, gw = blockIdx.x * 8 + (tx >> 6), nw = gridDim.x * 8;
    for (int row = gw; row < NTOK; row += nw) {
        float* xr = X + (size_t)row * DM; f32x4 v[8]; float ss = 0.f;
#pragma unroll
        for (int i = 0; i < 8; ++i) { v[i] = *(const f32x4*)(xr + (i * 64 + lane) * 4); ss += v[i][0] * v[i][0] + v[i][1] * v[i][1] + v[i][2] * v[i][2] + v[i][3] * v[i][3]; }
        ss = wave_sum(ss); const float rs = rsqrtf(ss * (1.0f / DM) + 1e-6f);
#pragma unroll
        for (int i = 0; i < 8; ++i) { const f32x4 gg = *(const f32x4*)(g + (i * 64 + lane) * 4); *(f32x4*)(xr + (i * 64 + lane) * 4) = v[i] * rs * gg; }
    }
}
#define MK_SPLIT 0
#define MK_DO8 true
#define MK_REPEAT 0

struct Args { const float* in[21]; float* out; unsigned char* ws; int ph_lo, ph_hi; };
__device__ __forceinline__ f32x16 mfma32(bf16x8 a, bf16x8 b, f32x16 c) { return __builtin_amdgcn_mfma_f32_32x32x16_bf16(a, b, c, 0, 0, 0); }
__device__ __forceinline__ f32x16 zero16() { f32x16 z; for (int i = 0; i < 16; ++i) z[i] = 0.f; return z; }
__device__ __forceinline__ bf16x8 ld_frag(const bf16_t* p) { return *(const bf16x8*)p; }
__device__ __forceinline__ bf16x8 mk_frag(u32x2 lo, u32x2 hi) { u32x4 v; v.x = lo.x; v.y = lo.y; v.z = hi.x; v.w = hi.y; return __builtin_bit_cast(bf16x8, v); }
__device__ __forceinline__ bf16x8 pack8(const f32x16& p, int s) { u32x4 v; v.x = cvt_pk_bf16(p[8 * s + 0], p[8 * s + 1]); v.y = cvt_pk_bf16(p[8 * s + 2], p[8 * s + 3]); v.z = cvt_pk_bf16(p[8 * s + 4], p[8 * s + 5]); v.w = cvt_pk_bf16(p[8 * s + 6], p[8 * s + 7]); return __builtin_bit_cast(bf16x8, v); }
__device__ __forceinline__ float log2_gamma(int h) { return log2f(1.0f - exp2f(-5.0f - (float)h)); }


__device__ __forceinline__ void lds_dma_copy(LAS unsigned char* dst, const bf16_t* src, int nkb) {
    const int w = __builtin_amdgcn_readfirstlane(threadIdx.x >> 6), lane = threadIdx.x & 63;
    for (int c = w; c < nkb; c += 8)
        __builtin_amdgcn_global_load_lds((const unsigned*)(src + (size_t)c * 512 + lane * 8), (LAS unsigned*)(dst + c * 1024), 16, 0, 0);
}
__device__ __forceinline__ void dma_wait_barrier() { asm volatile("s_waitcnt vmcnt(0)" ::: "memory"); __syncthreads(); }

__device__ __forceinline__ void compress_item(const Args& a, LAS unsigned char* lds, int ci) {
    const int tid = opaque_i(threadIdx.x), w = tid >> 6, lane = tid & 63, r32 = lane & 31, hi = lane >> 5;
    const int kv = ci >> 6, rr = ci & 63, bg = rr >> 3, nt = rr & 7, b = bg >> 1, g = bg & 1;
    unsigned char* ws = a.ws;
    const bf16_t* PROJ = (const bf16_t*)(ws + WS_BIG);
    const bf16_t* W1T = (const bf16_t*)(ws + (kv ? WS_CW1VT : WS_CW1KT));
    const bf16_t* W2T = (const bf16_t*)(ws + (kv ? WS_CW2VT : WS_CW2KT));
    const float* pe = a.in[kv ? 11 : 8];
    const int colbase = (kv ? PC_VC : PC_KC) + g * 128;
    const int n = nt * 32 + r32, nc = n < 255 ? n : 254;
    f32x16 acc[4];
#pragma unroll
    for (int i = 0; i < 4; ++i) acc[i] = zero16();
    const int ws_ = __builtin_amdgcn_readfirstlane(w);
    for (int st = 0; st < 8; ++st) {
#pragma unroll
        for (int i = 0; i < 16; ++i) { const int c = ws_ * 16 + i, ft = c >> 5, j = c & 31;
            __builtin_amdgcn_global_load_lds((const unsigned*)(W1T + ((size_t)(ft * 256 + st * 32 + j) * 64 + lane) * 8), (LAS unsigned*)(lds + c * 1024), 16, 0, 0); }
        u32x4 av[4]; f32x4 p0[4], p1[4];
#pragma unroll
        for (int i = 0; i < 4; ++i) { const int pr = w + 8 * i, l = 4 * st + (pr >> 3), ks = pr & 7;
            av[i] = *(const u32x4*)(PROJ + (size_t)(b * SEQ + 16 * nc + l) * PROJ_LD + colbase + 8 * hi + 16 * ks);
            p0[i] = *(const f32x4*)(pe + l * 128 + 8 * hi + 16 * ks); p1[i] = *(const f32x4*)(pe + l * 128 + 8 * hi + 16 * ks + 4); }
        dma_wait_barrier();
#pragma unroll
        for (int i = 0; i < 4; ++i) { const int pr = w + 8 * i;
            u32x4 bv; bv.x = cvt_pk_bf16(bflo(av[i].x) + p0[i][0], bfhi(av[i].x) + p0[i][1]); bv.y = cvt_pk_bf16(bflo(av[i].y) + p0[i][2], bfhi(av[i].y) + p0[i][3]);
            bv.z = cvt_pk_bf16(bflo(av[i].z) + p1[i][0], bfhi(av[i].z) + p1[i][1]); bv.w = cvt_pk_bf16(bflo(av[i].w) + p1[i][2], bfhi(av[i].w) + p1[i][3]);
            const bf16x8 bfr = __builtin_bit_cast(bf16x8, bv);
#pragma unroll
            for (int ft = 0; ft < 4; ++ft) acc[ft] = mfma32(*(const LAS bf16x8*)(lds + (ft * 32 + pr) * 1024 + lane * 16), bfr, acc[ft]); }
        __syncthreads();
    }
    LAS float* part = (LAS float*)lds;
#pragma unroll
    for (int ft = 0; ft < 4; ++ft)
#pragma unroll
        for (int r = 0; r < 16; ++r) { const int f = 32 * ft + (r & 3) + 8 * (r >> 2) + 4 * hi; part[w * 4096 + f * 32 + r32] = acc[ft][r]; }
    __syncthreads();
    float hv[8];
    { const int nn = tid & 31, fg = tid >> 5;
#pragma unroll
      for (int j = 0; j < 8; ++j) { float s = 0.f;
#pragma unroll
          for (int ww = 0; ww < 8; ++ww) s += part[ww * 4096 + (8 * fg + j) * 32 + nn];
          hv[j] = silu_f(s); } }
    __syncthreads();
    LAS bf16_t* Hs = (LAS bf16_t*)lds;
    { const int nn = tid & 31, fg = tid >> 5; u32x4 v; v.x = cvt_pk_bf16(hv[0], hv[1]); v.y = cvt_pk_bf16(hv[2], hv[3]); v.z = cvt_pk_bf16(hv[4], hv[5]); v.w = cvt_pk_bf16(hv[6], hv[7]);
      *(LAS u32x4*)(Hs + nn * 136 + 8 * fg) = v; }
    __syncthreads();
    if (w < 4) {
        f32x16 o = zero16();
#pragma unroll
        for (int ks = 0; ks < 8; ++ks) {
            const bf16x8 af = ld_frag(W2T + (size_t)(32 * w + r32) * 128 + 16 * ks + 8 * hi);
            const bf16x8 bf = *(const LAS bf16x8*)(Hs + r32 * 136 + 16 * ks + 8 * hi);
            o = mfma32(af, bf, o);
        }
        const bool live = n < 255;
        if (kv == 0) {
            bf16_t* dst = (bf16_t*)(ws + WS_KCMP) + ((size_t)(bg * 4 + (nt >> 1)) * 2 + (nt & 1)) * 8 * 512;
#pragma unroll
            for (int q = 0; q < 4; ++q) { u32x2 v; v.x = live ? cvt_pk_bf16(o[4 * q], o[4 * q + 1]) : 0u; v.y = live ? cvt_pk_bf16(o[4 * q + 2], o[4 * q + 3]) : 0u;
                *(u32x2*)(dst + ((2 * w + (q >> 1)) * 64 + (q & 1) * 32 + r32) * 8 + 4 * hi) = v; }
        } else {
            const int st = 2 * (nt & 1) + (r32 >> 4), hh = (r32 >> 2) & 1, slot = 4 * ((r32 >> 3) & 1) + (r32 & 3);
            bf16_t* dst = (bf16_t*)(ws + WS_VCMPT) + ((((size_t)(bg * 4 + (nt >> 1)) * 4 + w) * 4 + st) * 64 + hh * 32) * 8 + slot;
#pragma unroll
            for (int r = 0; r < 16; ++r) { const int o32 = (r & 3) + 8 * (r >> 2) + 4 * hi; dst[o32 * 8] = live ? (bf16_t)(cvt_pk_bf16(o[r], 0.f) & 0xffffu) : (bf16_t)0; }
        }
    }
    __syncthreads();
}

__device__ __forceinline__ void ret_u_item(const Args& a, LAS unsigned char* lds, int ui) {
    const int tid = opaque_i(threadIdx.x), w = tid >> 6, lane = tid & 63, r32 = lane & 31, hi = lane >> 5;
    const int h = (ui >> 5) & 3, n = ui & 31, bh = ui >> 5;
    unsigned char* ws = a.ws;
    lds_dma_copy(lds, (const bf16_t*)(ws + WS_KF) + ((size_t)bh * 128 + n * 4) * 8192, 64);
    lds_dma_copy(lds + 65536, (const bf16_t*)(ws + WS_VTF) + (size_t)ui * 32768, 64);
    dma_wait_barrier();
    const LAS unsigned char* KFl = lds + lane * 16; const LAS unsigned char* VTF = lds + 65536 + lane * 16;
    const int dt0 = 4 * (w >> 2), et0 = 2 * (w & 3);
    const float l2g = log2_gamma(h);
    u32x4 i1, i2;
    { const int e1 = r32 - 8 * hi, e2 = r32 - 16 - 8 * hi; unsigned v1[4], v2[4];
#pragma unroll
      for (int q = 0; q < 4; ++q) { v1[q] = (e1 == 2 * q ? 0x3F80u : 0u) | (e1 == 2 * q + 1 ? 0x3F800000u : 0u); v2[q] = (e2 == 2 * q ? 0x3F80u : 0u) | (e2 == 2 * q + 1 ? 0x3F800000u : 0u); }
      i1.x = v1[0]; i1.y = v1[1]; i1.z = v1[2]; i1.w = v1[3]; i2.x = v2[0]; i2.y = v2[1]; i2.z = v2[2]; i2.w = v2[3]; }
    const bf16x8 id1 = __builtin_bit_cast(bf16x8, i1), id2 = __builtin_bit_cast(bf16x8, i2);
    f32x16 acc[4][2];
#pragma unroll
    for (int i = 0; i < 4; ++i) { acc[i][0] = zero16(); acc[i][1] = zero16(); }
#pragma unroll 1
    for (int mt = 0; mt < 4; ++mt) {
        bf16x8 bf[2][2];
#pragma unroll
        for (int s = 0; s < 2; ++s) {
            const int ks = 2 * mt + s; float z[8];
#pragma unroll
            for (int j = 0; j < 8; ++j) { const int m = 16 * ks + 8 * (j >> 2) + 4 * hi + (j & 3); z[j] = exp2f((float)(127 - m) * l2g); }
#pragma unroll
            for (int et = 0; et < 2; ++et) {
                const u32x4 v = *(const LAS u32x4*)(VTF + ((et0 + et) * 8 + ks) * 1024);
                u32x4 o; o.x = cvt_pk_bf16(bflo(v.x) * z[0], bfhi(v.x) * z[1]); o.y = cvt_pk_bf16(bflo(v.y) * z[2], bfhi(v.y) * z[3]);
                o.z = cvt_pk_bf16(bflo(v.z) * z[4], bfhi(v.z) * z[5]); o.w = cvt_pk_bf16(bflo(v.w) * z[6], bfhi(v.w) * z[7]);
                bf[s][et] = __builtin_bit_cast(bf16x8, o);
            }
        }
#pragma unroll
        for (int dt = 0; dt < 4; ++dt) {
            f32x16 X = zero16();
            X = mfma32(*(const LAS bf16x8*)(KFl + (mt * 16 + 2 * (dt0 + dt)) * 1024), id1, X);
            X = mfma32(*(const LAS bf16x8*)(KFl + (mt * 16 + 2 * (dt0 + dt) + 1) * 1024), id2, X);
#pragma unroll
            for (int s = 0; s < 2; ++s) {
                const bf16x8 af = pack8(X, s);
                acc[dt][0] = mfma32(af, bf[s][0], acc[dt][0]); acc[dt][1] = mfma32(af, bf[s][1], acc[dt][1]);
            }
        }
    }
    bf16_t* UT = (bf16_t*)(ws + WS_UT) + (size_t)ui * 65536;
#pragma unroll
    for (int dt = 0; dt < 4; ++dt)
#pragma unroll
        for (int et = 0; et < 2; ++et)
#pragma unroll
            for (int q = 0; q < 4; ++q) { u32x2 v; v.x = cvt_pk_bf16(acc[dt][et][4 * q], acc[dt][et][4 * q + 1]); v.y = cvt_pk_bf16(acc[dt][et][4 * q + 2], acc[dt][et][4 * q + 3]);
                const int ksd = 2 * (dt0 + dt) + (q >> 1);
                *(u32x2*)(UT + ((((et0 + et) * 16 + ksd) * 64 + (q & 1) * 32 + r32) * 8 + 4 * hi)) = v; }
    __syncthreads();
}

__device__ __forceinline__ void ret_scan(const Args& a) {
    bf16_t* UT = (bf16_t*)(a.ws + WS_UT);
    for (int gid = blockIdx.x * 512 + threadIdx.x; gid < 16 * 8192; gid += gridDim.x * 512) {
        const int bh = gid >> 13, off = (gid & 8191) * 8, h = bh & 3;
        const float dec = exp2f(128.0f * log2_gamma(h));
        float st[8];
#pragma unroll
        for (int j = 0; j < 8; ++j) st[j] = 0.f;
        bf16_t* p = UT + (size_t)bh * 32 * 65536 + off;
        for (int n = 0; n < 32; ++n) {
            const u32x4 u = *(const u32x4*)(p + (size_t)n * 65536);
            u32x4 o; o.x = cvt_pk_bf16(st[0], st[1]); o.y = cvt_pk_bf16(st[2], st[3]); o.z = cvt_pk_bf16(st[4], st[5]); o.w = cvt_pk_bf16(st[6], st[7]);
            *(u32x4*)(p + (size_t)n * 65536) = o;
            st[0] = st[0] * dec + bflo(u.x); st[1] = st[1] * dec + bfhi(u.x); st[2] = st[2] * dec + bflo(u.y); st[3] = st[3] * dec + bfhi(u.y);
            st[4] = st[4] * dec + bflo(u.z); st[5] = st[5] * dec + bfhi(u.z); st[6] = st[6] * dec + bflo(u.w); st[7] = st[7] * dec + bfhi(u.w);
        }
    }
}

__device__ __forceinline__ void ret_y_item(const Args& a, LAS unsigned char* lds, int ui) {
    const int tid = opaque_i(threadIdx.x), w = tid >> 6, lane = tid & 63, r32 = lane & 31, hi = lane >> 5;
    const int n = ui & 31, bh = ui >> 5, h = bh & 3, b = bh >> 2;
    unsigned char* ws = a.ws;
    const bf16_t* PROJ = (const bf16_t*)(ws + WS_BIG);
    const bf16_t* QF = (const bf16_t*)(ws + WS_QF) + (size_t)bh * 128 * 8192 + lane * 8;
    lds_dma_copy(lds, (const bf16_t*)(ws + WS_UT) + (size_t)ui * 65536, 128);
    const LAS unsigned char* RT = lds + lane * 16;
    const LAS unsigned char* KF = lds + lane * 16;
    const LAS unsigned char* VTF = lds + 65536 + lane * 16;
    const size_t tok0 = (size_t)b * SEQ + n * 128;
    const int ct = w & 3, eh = w >> 2, c = 32 * ct + r32;
    const float l2g = log2_gamma(h);
    bf16x8 qf[16];
#pragma unroll
    for (int ks = 0; ks < 16; ++ks) qf[ks] = ld_frag(QF + ((n * 4 + ct) * 16 + ks) * 512);
    f32x16 acc[4];
#pragma unroll
    for (int i = 0; i < 4; ++i) acc[i] = zero16();
    dma_wait_barrier();
    {
#pragma unroll
      for (int ks = 0; ks < 16; ++ks)
#pragma unroll
          for (int et = 0; et < 4; ++et) acc[et] = mfma32(*(const LAS bf16x8*)(RT + ((4 * eh + et) * 16 + ks) * 1024), qf[ks], acc[et]);
      const float xi = exp2f((float)(c + 1) * l2g);
#pragma unroll
      for (int et = 0; et < 4; ++et) acc[et] = acc[et] * xi; }
    __syncthreads();
    lds_dma_copy(lds, (const bf16_t*)(ws + WS_KF) + ((size_t)bh * 128 + n * 4) * 8192, 64);
    lds_dma_copy(lds + 65536, (const bf16_t*)(ws + WS_VTF) + (size_t)ui * 32768, 64);
    dma_wait_barrier();
    for (int mt = 0; mt <= ct; ++mt) {
        f32x16 s = zero16();
#pragma unroll
        for (int ks = 0; ks < 16; ++ks) s = mfma32(*(const LAS bf16x8*)(KF + (mt * 16 + ks) * 1024), qf[ks], s);
#pragma unroll
        for (int r = 0; r < 16; ++r) { const int m = 32 * mt + (r & 3) + 8 * (r >> 2) + 4 * hi; const int df = c - m; s[r] = df >= 0 ? s[r] * exp2f((float)df * l2g) : 0.f; }
#pragma unroll
        for (int s2 = 0; s2 < 2; ++s2) {
            const bf16x8 pf = pack8(s, s2);
#pragma unroll
            for (int et = 0; et < 4; ++et) acc[et] = mfma32(*(const LAS bf16x8*)(VTF + ((4 * eh + et) * 8 + 2 * mt + s2) * 1024), pf, acc[et]);
        }
    }
    float s1 = 0.f, s2 = 0.f;
#pragma unroll
    for (int et = 0; et < 4; ++et)
#pragma unroll
        for (int r = 0; r < 16; ++r) { s1 += acc[et][r]; s2 += acc[et][r] * acc[et][r]; }
    s1 += __shfl_xor(s1, 32); s2 += __shfl_xor(s2, 32);
    LAS float* st = (LAS float*)(lds + 131072);
    if (hi == 0) { st[(eh * 128 + c) * 2] = s1; st[(eh * 128 + c) * 2 + 1] = s2; }
    __syncthreads();
    const float t1 = st[c * 2] + st[(128 + c) * 2], t2 = st[c * 2 + 1] + st[(128 + c) * 2 + 1];
    const float mu = t1 * (1.0f / 256.0f), var = fmaxf(t2 * (1.0f / 256.0f) - mu * mu, 0.f), rstd = rsqrtf(var + 1e-6f);
    const float* gain = a.in[7] + h * 256;
    const bf16_t* grow = PROJ + (tok0 + c) * PROJ_LD + PC_RG + h * 256;
    bf16_t* yrow = (bf16_t*)(ws + WS_XN) + (tok0 + c) * DM + h * 256;
    u32x2 gv[4][4];
#pragma unroll
    for (int et = 0; et < 4; ++et)
#pragma unroll
        for (int q = 0; q < 4; ++q) gv[et][q] = *(const u32x2*)(grow + 128 * eh + 32 * et + 8 * q + 4 * hi);
    __builtin_amdgcn_sched_barrier(0);
#pragma unroll
    for (int et = 0; et < 4; ++et) {
        f32x4 gn[4];
#pragma unroll
        for (int q = 0; q < 4; ++q) gn[q] = *(const f32x4*)(gain + 128 * eh + 32 * et + 8 * q + 4 * hi);
#pragma unroll
        for (int q = 0; q < 4; ++q) {
            const int e = 128 * eh + 32 * et + 8 * q + 4 * hi;
            const float y0 = (acc[et][4 * q] - mu) * rstd * gn[q][0] * silu_f(bflo(gv[et][q].x)), y1 = (acc[et][4 * q + 1] - mu) * rstd * gn[q][1] * silu_f(bfhi(gv[et][q].x));
            const float y2 = (acc[et][4 * q + 2] - mu) * rstd * gn[q][2] * silu_f(bflo(gv[et][q].y)), y3 = (acc[et][4 * q + 3] - mu) * rstd * gn[q][3] * silu_f(bfhi(gv[et][q].y));
            u32x2 o; o.x = cvt_pk_bf16(y0, y1); o.y = cvt_pk_bf16(y2, y3);
            *(u32x2*)(yrow + e) = o;
        }
    }
    __syncthreads();
}

constexpr int NSA_KB = 0, NSA_VB = 49152, NSA_BIAS = 98304, NSA_IMPA = NSA_BIAS + 2112, NSA_IMPB = NSA_IMPA + 8 * 8 * 66 * 4, NSA_SELM = NSA_IMPB + 8 * 8 * 66 * 4, NSA_LIST = NSA_SELM + 512, NSA_END = NSA_LIST + 4 * 160;
static_assert(NSA_END <= 147456 - 64, "NSA LDS map");
constexpr float LOG2E = 1.4426950408889634f;
__device__ __forceinline__ int t5_bucket_dev(int n) {
    if (n < 16) return n;
    const float v = logf((float)n / 16.0f) / 2.0794415416798357f * 16.0f;
    const int l = 16 + (int)v; return l < 31 ? l : 31;
}
struct TileSrc { const bf16_t* k; const bf16_t* v; };
__device__ __forceinline__ TileSrc nsa_src(unsigned char* ws, int mode, int idx, int b, int g) {
    TileSrc s; const int bg = b * 2 + g;
    if (mode <= 1) { s.k = (const bf16_t*)(ws + WS_KCMP) + (size_t)(bg * 4 + idx) * 8192; s.v = (const bf16_t*)(ws + WS_VCMPT) + (size_t)(bg * 4 + idx) * 8192; }
    else if (mode == 2) { s.k = (const bf16_t*)(ws + WS_KWF) + (size_t)(bg * 64 + idx) * 8192; s.v = (const bf16_t*)(ws + WS_VWF) + (size_t)(bg * 64 + idx) * 8192; }
    else { s.k = (const bf16_t*)(ws + WS_KSF) + (size_t)(bg * 64 + idx) * 8192; s.v = (const bf16_t*)(ws + WS_VSF) + (size_t)(bg * 64 + idx) * 8192; }
    return s;
}
__device__ __forceinline__ void nsa_fill(LAS unsigned char* lds, int buf, const TileSrc& s) {
    const int tx = opaque_i(threadIdx.x); const int w = __builtin_amdgcn_readfirstlane(tx >> 6), lane = tx & 63;
#pragma unroll
    for (int i = 0; i < 2; ++i) {
        const int c = w * 2 + i;
        __builtin_amdgcn_global_load_lds((const unsigned*)(s.k + c * 512 + lane * 8), (LAS unsigned*)(lds + NSA_KB + buf * 16384 + c * 1024), 16, 0, 0);
        __builtin_amdgcn_global_load_lds((const unsigned*)(s.v + c * 512 + lane * 8), (LAS unsigned*)(lds + NSA_VB + buf * 16384 + c * 1024), 16, 0, 0);
    }
}
__device__ __forceinline__ float max_xor32(float x) {
    float a = x, b = x;
    asm volatile("s_nop 1\n\tv_permlane32_swap_b32 %0, %1\n\ts_nop 1" : "+v"(a), "+v"(b));
    return fmaxf(a, b);
}
__device__ __forceinline__ void nsa_qk(LAS unsigned char* lds, int buf, int lane_in, const bf16x8 (&qf)[8], f32x16 (&s)[2]) {
    const int lane = opaque_i(lane_in); const int r32 = lane & 31, hi = lane >> 5;
#pragma unroll
    for (int kt = 0; kt < 2; ++kt) { s[kt] = zero16();
        const LAS unsigned char* kp = lds + NSA_KB + buf * 16384 + kt * 8192 + lane * 16;
#pragma unroll
        for (int ks = 0; ks < 8; ++ks) s[kt] = mfma32(*(const LAS bf16x8*)(kp + ks * 1024), qf[ks], s[kt]); }
}
template <int MODE>
__device__ __forceinline__ void nsa_tile(LAS unsigned char* lds, int buf, int idx, int qb, int w, int lane_in, f32x16 (&s)[2], f32x16 (&O)[4], float& mrun, float& lrun,
                                         float m_fin, float invl, unsigned long long mysel, bool do_next, int bufn, const bf16x8 (&qf)[8], f32x16 (&sn)[2]) {
    const int lane = opaque_i(lane_in); const int r32 = lane & 31, hi = lane >> 5, hd = lane & 3, tl = (lane & 31) >> 2;
    const int tokq = 64 * qb + 8 * w + tl;
    LAS float* biasl = (LAS float*)(lds + NSA_BIAS);
    const float c1 = 0.08838834764831845f * LOG2E;
    int relbase, relmax; bool lanevalid = true, far; constexpr int kstride = (MODE <= 1) ? 16 : 1;
    if (MODE <= 1) { relbase = tokq - 31 - 1024 * idx; relmax = 1 << 30; far = false; }
    else if (MODE == 2) { relbase = tokq - 64 * idx; relmax = 512; far = (idx <= qb - 3) && (idx >= qb - 7); }
    else { relbase = tokq - 64 * idx; relmax = 1 << 30; far = (idx <= qb - 3); lanevalid = (mysel >> idx) & 1ull; }
    float cs = 1.0f, offl = 0.0f;
    if (far) {
        cs = c1; offl = lanevalid ? biasl[hd * 132 + 128] : -1e30f;
    } else {
#pragma unroll
        for (int kt = 0; kt < 2; ++kt)
#pragma unroll
            for (int hf = 0; hf < 2; ++hf) {
                float bv[8];
#pragma unroll
                for (int r8 = 0; r8 < 8; ++r8) { const int r = 8 * hf + r8; const int kk = 32 * kt + (r & 3) + 8 * (r >> 2) + 4 * hi; const int rel = relbase - kstride * kk;
                    const int ri = rel < 0 ? 0 : (rel > 128 ? 128 : rel); bv[r8] = biasl[hd * 132 + ri]; }
#pragma unroll
                for (int r8 = 0; r8 < 8; ++r8) asm volatile("" : "+v"(bv[r8]));
#pragma unroll
                for (int r8 = 0; r8 < 8; ++r8) { const int r = 8 * hf + r8; const int kk = 32 * kt + (r & 3) + 8 * (r >> 2) + 4 * hi; const int rel = relbase - kstride * kk;
                    const bool v = lanevalid && rel >= 0 && rel < relmax;
                    s[kt][r] = v ? s[kt][r] * c1 + bv[r8] : -1e30f; }
            }
    }
    { const LAS unsigned char* kp = lds + NSA_KB + bufn * 16384 + lane * 16;
#pragma unroll
      for (int kt = 0; kt < 2; ++kt) { sn[kt] = zero16();
#pragma unroll
          for (int ks = 0; ks < 8; ++ks) sn[kt] = mfma32(*(const LAS bf16x8*)(kp + kt * 8192 + ks * 1024), qf[ks], sn[kt]); } }
    if (MODE == 1) {
#pragma unroll
        for (int kt = 0; kt < 2; ++kt)
#pragma unroll
            for (int r = 0; r < 16; ++r) s[kt][r] = (s[kt][r] > -1e29f) ? __builtin_amdgcn_exp2f(s[kt][r] - m_fin) * invl : 0.f;
        LAS float* impa = (LAS float*)(lds + NSA_IMPA) + w * 8 * 66;
        LAS float* impb = (LAS float*)(lds + NSA_IMPB) + w * 8 * 66;
#pragma unroll
        for (int kt = 0; kt < 2; ++kt)
#pragma unroll
            for (int q = 0; q < 4; ++q) {
                float A_ = s[kt][4 * q] + s[kt][4 * q + 1] + s[kt][4 * q + 2] + 0.5f * s[kt][4 * q + 3], B_ = 0.5f * s[kt][4 * q + 3];
                A_ += __shfl_xor(A_, 1); A_ += __shfl_xor(A_, 2); B_ += __shfl_xor(B_, 1); B_ += __shfl_xor(B_, 2);
                const int j = 8 * (2 * idx + kt) + 2 * q + hi;
                if (hd == 0) { impa[tl * 66 + j] = A_; impb[tl * 66 + j + 1] = B_; }
            }
    } else {
        float tm = -3.0e38f;
#pragma unroll
        for (int kt = 0; kt < 2; ++kt)
#pragma unroll
            for (int r = 0; r < 16; r += 2) tm = fmaxf(fmaxf(tm, s[kt][r]), s[kt][r + 1]);
        tm = tm * cs + offl;
        tm = max_xor32(tm);
        const float mn = fmaxf(mrun, tm), al = __builtin_amdgcn_exp2f(mrun - mn); float ps = 0.f;
        const float om = offl - mn;
#pragma unroll
        for (int kt = 0; kt < 2; ++kt)
#pragma unroll
            for (int r = 0; r < 16; ++r) { const float p = __builtin_amdgcn_exp2f(s[kt][r] * cs + om); s[kt][r] = p; ps += p; }
        lrun = lrun * al + ps; mrun = mn;
        if (MODE != 0) {
            if (__builtin_amdgcn_ballot_w64(al != 1.0f)) {
#pragma unroll
                for (int dt = 0; dt < 4; ++dt) O[dt] = O[dt] * al;
            }
        }
    }
    if (MODE != 0) {
        __builtin_amdgcn_iglp_opt(0);
#pragma unroll
        for (int kt = 0; kt < 2; ++kt)
#pragma unroll
            for (int s2 = 0; s2 < 2; ++s2) {
                const bf16x8 pf = pack8(s[kt], s2);
#pragma unroll
                for (int dt = 0; dt < 4; ++dt) {
                    const LAS unsigned char* vp = lds + NSA_VB + buf * 16384 + (dt * 4 + 2 * kt + s2) * 1024 + lane * 16;
                    O[dt] = mfma32(*(const LAS bf16x8*)vp, pf, O[dt]);
                }
            }
    }
}
template <int MODE>
__device__ __forceinline__ void nsa_branch(unsigned char* ws, LAS unsigned char* lds, unsigned long long tmask, int b, int g, int qb, int w, int lane, const bf16x8 (&qf)[8], f32x16 (&O)[4],
                                           float& mrun, float& lrun, float m_fin, float invl, unsigned long long mysel) {
    int bc = 0;
    f32x16 sc[2];
    nsa_fill(lds, 0, nsa_src(ws, MODE, __builtin_ctzll(tmask), b, g));
    { const unsigned long long t1 = tmask & (tmask - 1); if (t1) nsa_fill(lds, 1, nsa_src(ws, MODE, __builtin_ctzll(t1), b, g)); }
    dma_wait_barrier();
    nsa_qk(lds, 0, lane, qf, sc);
    while (tmask) {
        const int idx = __builtin_ctzll(tmask); tmask &= tmask - 1;
        const unsigned long long t2 = tmask & (tmask - 1);
        const int bn = (bc == 2) ? 0 : bc + 1, bf = (bn == 2) ? 0 : bn + 1;
        if (t2) nsa_fill(lds, bf, nsa_src(ws, MODE, __builtin_ctzll(t2), b, g));
        f32x16 sn[2];
        nsa_tile<MODE>(lds, bc, idx, qb, w, lane, sc, O, mrun, lrun, m_fin, invl, mysel, tmask != 0ull, bn, qf, sn);
        dma_wait_barrier();
        if (tmask) { sc[0] = sn[0]; sc[1] = sn[1]; }
        bc = bn;
    }
}
__device__ __forceinline__ void nsa_accum(bf16_t* yrow, const f32x16 (&O)[4], float f, bool first) {
    u32x2 o[4][4];
#pragma unroll
    for (int dt = 0; dt < 4; ++dt)
#pragma unroll
        for (int q = 0; q < 4; ++q) { if (first) { o[dt][q].x = 0u; o[dt][q].y = 0u; } else o[dt][q] = *(const u32x2*)(yrow + 32 * dt + 8 * q); }
    __builtin_amdgcn_sched_barrier(0);
#pragma unroll
    for (int dt = 0; dt < 4; ++dt)
#pragma unroll
        for (int q = 0; q < 4; ++q) {
            u32x2 v = o[dt][q];
            v.x = cvt_pk_bf16(bflo(v.x) + f * O[dt][4 * q], bfhi(v.x) + f * O[dt][4 * q + 1]); v.y = cvt_pk_bf16(bflo(v.y) + f * O[dt][4 * q + 2], bfhi(v.y) + f * O[dt][4 * q + 3]);
            *(u32x2*)(yrow + 32 * dt + 8 * q) = v; }
}
__device__ __forceinline__ void nsa_finish(const Args& a, int b, int g, int qb, int br, const f32x16 (&O)[4], float scale, bool first) {
    const int tx = opaque_i(threadIdx.x); const int lane = tx & 63, w = tx >> 6; const int r32 = lane & 31, hi = lane >> 5, tl = r32 >> 2, hd = r32 & 3;
    const size_t grow = (size_t)b * SEQ + 64 * qb + 8 * w + tl;
    const bf16_t* PROJ = (const bf16_t*)(a.ws + WS_BIG);
    const float gate = sigmoid_f(bf2f(PROJ[grow * PROJ_LD + PC_GATE + (4 * g + hd) * 3 + br]));
    bf16_t* yrow = (bf16_t*)(a.ws + WS_XN) + grow * DM + 1024 + (4 * g + hd) * 128 + 4 * hi;
    nsa_accum(yrow, O, gate * scale, first);
}
__device__ __forceinline__ void nsa_item(const Args& a, LAS unsigned char* lds, int b, int g, int qb) {
    const int tid = opaque_i(threadIdx.x), w = tid >> 6, lane = tid & 63, r32 = lane & 31, hi = lane >> 5, tl = r32 >> 2, hd = r32 & 3;
    unsigned char* ws = a.ws;
    const bf16_t* PROJ = (const bf16_t*)(ws + WS_BIG);
    const int tokq = 64 * qb + 8 * w + tl;
    const size_t grow = (size_t)b * SEQ + tokq;
    LAS float* biasl = (LAS float*)(lds + NSA_BIAS);
    LAS float* impa = (LAS float*)(lds + NSA_IMPA) + w * 8 * 66;
    LAS float* impb = (LAS float*)(lds + NSA_IMPB) + w * 8 * 66;
    for (int i = tid; i < 4 * 129; i += 512) { const int hh = i / 129, rel = i - hh * 129; biasl[hh * 132 + rel] = a.in[19][(4 * g + hh) * 32 + t5_bucket_dev(rel)] * LOG2E; }
    for (int i = tid; i < 2 * 8 * 8 * 66; i += 512) ((LAS float*)(lds + NSA_IMPA))[i] = 0.f;
    const int nc = (4 * qb + 2) / 64 + 1;
    bf16x8 qf[8];
    { const bf16_t* qrow = PROJ + grow * PROJ_LD + PC_NQ + (4 * g + hd) * 128 + 8 * hi;
#pragma unroll
      for (int ks = 0; ks < 8; ++ks) qf[ks] = ld_frag(qrow + 16 * ks); }
    f32x16 O[4];
#pragma unroll
    for (int dt = 0; dt < 4; ++dt) O[dt] = zero16();
    float mrun = -1e30f, lrun = 0.f;
    __syncthreads();
    const unsigned long long cmask = (1ull << nc) - 1ull;
    if (__builtin_amdgcn_readfirstlane(w) < 4) __builtin_amdgcn_s_setprio(2);
    nsa_branch<0>(ws, lds, cmask, b, g, qb, w, lane, qf, O, mrun, lrun, 0.f, 0.f, 0ull);
    const float m_fin = mrun; const float invl = fast_rcp(lrun + __shfl_xor(lrun, 32));
    mrun = -1e30f; lrun = 0.f;
    nsa_branch<1>(ws, lds, cmask, b, g, qb, w, lane, qf, O, mrun, lrun, m_fin, invl, 0ull);
    nsa_finish(a, b, g, qb, 0, O, 1.0f, true);
    unsigned long long mysel, U;
    { const int tk = lane >> 3, jj = lane & 7; float sc[8];
#pragma unroll
      for (int q = 0; q < 8; ++q) { const int j = jj * 8 + q; const float v = impa[tk * 66 + j] + impb[tk * 66 + j];
          const bool forced = (j == 0) || (j == qb) || (j == qb - 1); sc[q] = forced ? 1e4f : (j <= qb ? v : -1e30f); }
      __syncthreads();
#pragma unroll
      for (int q = 0; q < 8; ++q) impa[tk * 66 + jj * 8 + q] = sc[q];
      __syncthreads();
      int rank[8];
#pragma unroll
      for (int q = 0; q < 8; ++q) rank[q] = 0;
      for (int ii = 0; ii < 64; ++ii) { const float vi = impa[tk * 66 + ii];
#pragma unroll
          for (int q = 0; q < 8; ++q) rank[q] += ((vi > sc[q]) || (vi == sc[q] && ii < jj * 8 + q)) ? 1 : 0; }
      unsigned bits = 0;
#pragma unroll
      for (int q = 0; q < 8; ++q) bits |= ((rank[q] < 16 && sc[q] > -5e29f) ? 1u : 0u) << q;
      ((LAS unsigned char*)(lds + NSA_SELM))[(8 * w + tk) * 8 + jj] = (unsigned char)bits; }
    __syncthreads();
    { const LAS unsigned long long* sm = (const LAS unsigned long long*)(lds + NSA_SELM);
      const int t2 = opaque_i(threadIdx.x);
      mysel = sm[8 * (t2 >> 6) + ((t2 & 31) >> 2)];
      unsigned long long u = sm[t2 & 63];
#pragma unroll
      for (int o = 32; o >= 1; o >>= 1) u |= __shfl_xor(u, o);
      U = u; }
#pragma unroll
    for (int dt = 0; dt < 4; ++dt) O[dt] = zero16();
    mrun = -1e30f; lrun = 0.f;
    { const int t0 = qb > 8 ? qb - 8 : 0; const unsigned long long wmask = ((qb == 63) ? ~0ull : ((1ull << (qb + 1)) - 1ull)) & ~((1ull << t0) - 1ull);
      nsa_branch<2>(ws, lds, wmask, b, g, qb, w, lane, qf, O, mrun, lrun, 0.f, 0.f, 0ull); }
    nsa_finish(a, b, g, qb, 2, O, fast_rcp(lrun + __shfl_xor(lrun, 32)), false);
#pragma unroll
    for (int dt = 0; dt < 4; ++dt) O[dt] = zero16();
    mrun = -1e30f; lrun = 0.f;
    { const unsigned long long smask = U & ((qb == 63) ? ~0ull : ((1ull << (qb + 1)) - 1ull));
      nsa_branch<3>(ws, lds, smask, b, g, qb, w, lane, qf, O, mrun, lrun, 0.f, 0.f, mysel); }
    nsa_finish(a, b, g, qb, 1, O, fast_rcp(lrun + __shfl_xor(lrun, 32)), false);
    __builtin_amdgcn_s_setprio(0);
    __syncthreads();
}

__device__ __forceinline__ void phase5(const Args& a, LAS unsigned char* lds) {
    const int bid = blockIdx.x, G = gridDim.x;
    if (G == 256) {
        if (bid < 128) { compress_item(a, lds, bid); ret_u_item(a, lds, 384 + bid); }
        else { for (int k = 0; k < 3; ++k) ret_u_item(a, lds, (bid - 128) + 128 * k); }
    } else for (int it = bid; it < 128 + 512; it += G) { if (it < 128) compress_item(a, lds, it); else ret_u_item(a, lds, it - 128); }
}
__device__ __forceinline__ void phase6(const Args& a, LAS unsigned char* lds) { ret_scan(a); }
template <int WHICH> __device__ __forceinline__ void phase7(const Args& a, LAS unsigned char* lds) {
    const int G = gridDim.x;
    if (WHICH & 1) for (int it = blockIdx.x; it < 512; it += G) {
        const int round = it / G, x = it % G; int qb, bg;
        if (G == 256) { bg = x & 7; qb = (round == 0) ? 63 - (x >> 3) : (x >> 3); } else { bg = it & 7; qb = 63 - (it >> 3); }
        nsa_item(a, lds, bg >> 1, bg & 1, qb);
    }
    if (WHICH & 2) for (int it = blockIdx.x; it < 512; it += G) ret_y_item(a, lds, it);
}

#define XB_TMO      128
#define XB_XCNT(j)  (256  + 64 * (j))
#define XB_XSUB(j)  (1280 + 64 * (j))
#define XB_XGEN(j)  (2304 + 64 * (j))
#define XB_TOP      3328
#define XB_TOPGEN   3392
#define XCD_BAR_WORDS 3456
#define XB_SPIN_CAP (1u << 18)

__device__ __forceinline__ unsigned xb_ld(unsigned* p)              { return __hip_atomic_load(p, __ATOMIC_RELAXED, __HIP_MEMORY_SCOPE_AGENT); }
__device__ __forceinline__ unsigned xb_add(unsigned* p, unsigned v) { return __hip_atomic_fetch_add(p, v, __ATOMIC_RELAXED, __HIP_MEMORY_SCOPE_AGENT); }
__device__ __forceinline__ unsigned xb_xcc_id() { return (unsigned)__builtin_amdgcn_s_getreg((3 << 11) | 20) & 0xFu; }
#define XB_SPIN(cond, bar) do { unsigned _sp = 0; while (cond) { __builtin_amdgcn_s_sleep(1); \
    if ((++_sp & 255u) == 0u) { if (xb_ld(&(bar)[XB_TMO])) break; if (_sp > XB_SPIN_CAP) { atomicAdd(&(bar)[XB_TMO], 1u); break; } } } } while (0)

struct XcdBarrier {
    unsigned* bar; unsigned x;
    volatile LAS unsigned* st;
};

__device__ __forceinline__ XcdBarrier xcd_barrier_post(unsigned* bar, volatile LAS unsigned* st) {
    XcdBarrier b; b.bar = bar; b.x = xb_xcc_id(); b.st = st;
    if (threadIdx.x == 0) (void)xb_add(&bar[XB_XCNT(b.x)], 1u);
    return b;
}
__device__ __forceinline__ void xcd_barrier_complete(unsigned* bar, unsigned x, unsigned& nloc, unsigned& nx) {
    const unsigned G = gridDim.x * gridDim.y * gridDim.z;
    unsigned sum, cnt, mine, sp = 0u;
    for (;;) {
        sum = 0u; cnt = 0u; mine = 0u;
#pragma unroll
        for (unsigned j = 0; j < 16; ++j) { const unsigned c = xb_ld(&bar[XB_XCNT(j)]); sum += c; cnt += (c > 0u) ? 1u : 0u; mine = (j == x) ? c : mine; }
        if (sum == G) break;
        __builtin_amdgcn_s_sleep(1);
        if ((++sp & 255u) == 0u) { if (xb_ld(&bar[XB_TMO])) break; if (sp > XB_SPIN_CAP) { atomicAdd(&bar[XB_TMO], 1u); break; } }
    }
    nloc = mine > 0u ? mine : 1u; nx = cnt > 0u ? cnt : 1u;
}

__device__ __forceinline__ void xcd_barrier(const XcdBarrier& b) {
    asm volatile("s_waitcnt vmcnt(0)" ::: "memory");
    __syncthreads();
    if (threadIdx.x == 0) {
        unsigned* bar = b.bar;
        __builtin_amdgcn_s_waitcnt(0);
        unsigned nloc = b.st[0], nx = b.st[1];
        if (nloc == 0u) { xcd_barrier_complete(bar, b.x, nloc, nx); b.st[0] = nloc; b.st[1] = nx; }
        const unsigned old = xb_add(&bar[XB_XSUB(b.x)], 1u);
        const unsigned gen = old / nloc;
        if (old + 1u == (gen + 1u) * nloc) {
            __builtin_amdgcn_fence(__ATOMIC_RELEASE, "agent");
            asm volatile("s_waitcnt vmcnt(0)" ::: "memory");
            const unsigned og = xb_add(&bar[XB_TOP], 1u);
            const unsigned tg = og / nx;
            if (og + 1u == (tg + 1u) * nx) xb_add(&bar[XB_TOPGEN], 1u);
            else XB_SPIN(xb_ld(&bar[XB_TOPGEN]) == tg, bar);
            __builtin_amdgcn_fence(__ATOMIC_ACQUIRE, "agent");
            xb_add(&bar[XB_XGEN(b.x)], 1u);
            asm volatile("s_waitcnt vmcnt(0)" ::: "memory");
        } else {
            XB_SPIN(xb_ld(&bar[XB_XGEN(b.x)]) == gen, bar);
            __builtin_amdgcn_fence(__ATOMIC_ACQUIRE, "agent");
            asm volatile("s_waitcnt vmcnt(0)" ::: "memory");
        }
    }
    __syncthreads();
}

constexpr int LDS_BYTES = 147456;
constexpr int NPHASE = 13;

__global__ void __launch_bounds__(512, 2) mk_fwd(Args a) {
    extern __shared__ __attribute__((aligned(16))) unsigned char lds_raw[];
    LAS unsigned char* lds = (LAS unsigned char*)lds_raw;
    cg::grid_group grid = cg::this_grid();
    unsigned char* ws = a.ws;
    const int tid = threadIdx.x, bid = blockIdx.x, G = gridDim.x;
    bf16_t* XN = (bf16_t*)(ws + WS_XN);
    bf16_t* X1B = (bf16_t*)a.out; bf16_t* X2B = (bf16_t*)a.out + (size_t)NTOK * DM;
    volatile LAS unsigned* bst = (volatile LAS unsigned*)(lds + LDS_BYTES - 64);
    if (tid < 2) bst[tid] = 0u;
    __syncthreads();
    XcdBarrier bar = xcd_barrier_post((unsigned*)ws, bst);
    if (a.ph_lo < 0) grid.sync();
#define PH_ON(k) (a.ph_lo <= (k) && (k) < a.ph_hi)
#define PH_END(k) if ((k) + 1 < a.ph_hi) { xcd_barrier(bar); }
#ifndef MK_REPEAT
#define MK_REPEAT 0
#endif
#define REP(k) for (int rep_ = 0; rep_ < (((MK_REPEAT >> (k)) & 1) ? 2 : 1); ++rep_)
    {
        if (PH_ON(0)) REP(0) {
            { LAS float* tile = (LAS float*)lds; f32x4 v[8]; int it = bid;
              if (it < 3364) wconv_load(p0_witem(it, a.in, ws), v);
              while (it < 3364) { wconv_commit(v, tile); __syncthreads(); const int nx = it + G; if (nx < 3364) wconv_load(p0_witem(nx, a.in, ws), v);
                  wconv_drain(p0_witem(it, a.in, ws), tile); __syncthreads(); it = nx; } }
            { float* rot = (float*)(ws + WS_ROT); float* rott = (float*)(ws + WS_ROTT);
              for (int idx = bid * 512 + tid; idx < SEQ * 128; idx += G * 512) {
                  const int pos = idx >> 7, dd = idx & 127;
                  const float inv = exp2f(-((float)dd * (1.0f / 128.0f)) * 13.287712379549449f);
                  const float ang = (float)pos * inv;
                  double r = (double)ang * 0.15915494309189535; r -= floor(r); const float rf = (float)r;
                  const float cs = __builtin_amdgcn_cosf(rf), sn = __builtin_amdgcn_sinf(rf);
                  rot[idx] = cs; rot[SEQ * 128 + idx] = sn; rott[dd * SEQ + pos] = cs; rott[128 * SEQ + dd * SEQ + pos] = sn;
              } }
            { float* ssq = (float*)(ws + WS_SSQ); for (int i = bid * 512 + tid; i < 3 * NTOK; i += G * 512) ssq[i] = 0.f; }
            rms_rows_bf16(a.in[0], a.in[1], XN);
            PH_END(0)
        }
        if (PH_ON(1)) REP(1) {
            pg8::StaticOrder S; S.init(XN, ws + WS_W13T, NTOK, 2 * DFF, DM, G, bid);
            EpiSwiglu E; E.O = (bf16_t*)(ws + WS_BIG); E.ldc = DFF; E.ssq = nullptr;
            pg8::gemm_phase<EpiSwiglu, pg8::StaticOrder>(lds, DM, S, E);
            PH_END(1)
        }
        if (PH_ON(2)) REP(2) {
            pg8::StaticOrder S; S.init(ws + WS_BIG, ws + WS_W2T, NTOK, DM, DFF, G, bid);
            EpiResid E; E.R = a.in[0]; E.Rb = nullptr; E.scale = 0.5f; E.Xb = X1B; E.ssq = (float*)(ws + WS_SSQ);
            pg8::gemm_phase<EpiResid, pg8::StaticOrder>(lds, DFF, S, E);
            PH_END(2)
        }
        if (PH_ON(4)) REP(4) {
            WinOrder S; S.XN = (const char*)X1B; S.WT = (const char*)(ws + WS_WINT); S.G = G; S.c = bid; S.tstep = (size_t)256 * DM * 2;
            EpiProj E; E.ws = ws;
            pg8::gemm_phase<EpiProj, WinOrder>(lds, DM, S, E);
            { LAS float* tile = (LAS float*)lds; f32x4 v[8];
              const int extra = (G == 256 && bid >= 192) ? 7 : 0, base = (G == 256) ? 448 : 0;
              const int nrest = (2112 - base - bid + G - 1) / G > 0 ? (2112 - base - bid + G - 1) / G : 0, nit = extra + nrest;
#define MK_WIDX(j) ((j) < extra ? (bid - 192) * 7 + (j) : base + bid + G * ((j) - extra))
              __syncthreads();
              if (nit > 0) wconv_load(ffn_witem(MK_WIDX(0), a.in[16], a.in[17], a.in[18], ws, a.in[15]), v);
              for (int j = 0; j < nit; ++j) { wconv_commit(v, tile); __syncthreads(); if (j + 1 < nit) wconv_load(ffn_witem(MK_WIDX(j + 1), a.in[16], a.in[17], a.in[18], ws, a.in[15]), v);
                  wconv_drain(ffn_witem(MK_WIDX(j), a.in[16], a.in[17], a.in[18], ws, a.in[15]), tile); __syncthreads(); }
#undef MK_WIDX
            }
            PH_END(4)
        }
        if (PH_ON(5)) REP(5) { phase5(a, lds); PH_END(5) }
        if (PH_ON(6)) { phase6(a, lds); PH_END(6) }
        if (PH_ON(7)) REP(7) { phase7<3>(a, lds); PH_END(7) }
        if (PH_ON(8) && MK_DO8) {
            pg8::StaticOrder S; S.init(XN, ws + WS_WOUTT, NTOK, DM, DM, G, bid);
            EpiResid E; E.R = nullptr; E.Rb = X1B; E.scale = 1.0f; E.Xb = X2B; E.ssq = (float*)(ws + WS_SSQ) + NTOK;
            pg8::gemm_phase<EpiResid, pg8::StaticOrder>(lds, DM, S, E);
            PH_END(8)
        }
        if (PH_ON(10)) {
            pg8::StaticOrder S; S.init(X2B, ws + WS_W13T, NTOK, 2 * DFF, DM, G, bid);
            EpiSwiglu E; E.O = (bf16_t*)(ws + WS_BIG); E.ldc = DFF; E.ssq = (const float*)(ws + WS_SSQ) + NTOK;
            pg8::gemm_phase<EpiSwiglu, pg8::StaticOrder>(lds, DM, S, E);
            PH_END(10)
        }
        if (PH_ON(11)) {
            pg8::StaticOrder S; S.init(ws + WS_BIG, ws + WS_W2T, NTOK, DM, DFF, G, bid);
            EpiResid E; E.R = nullptr; E.Rb = X2B; E.scale = 0.5f; E.Xb = XN; E.ssq = (float*)(ws + WS_SSQ) + 2 * NTOK;
            pg8::gemm_phase<EpiResid, pg8::StaticOrder>(lds, DFF, S, E);
            PH_END(11)
        }
#ifdef MK_EXTRA_SYNCS
        if (PH_ON(12)) { for (int i_ = 0; i_ < MK_EXTRA_SYNCS; ++i_) xcd_barrier(bar); }
#endif
        if (PH_ON(12)) rms_final_from_bf16(XN, (const float*)(ws + WS_SSQ) + 2 * NTOK, a.in[20], a.out);
#ifdef MK_EXTRA_PHASE
        if (PH_ON(13)) phase7<1>(a, lds);
        if (PH_ON(14)) phase7<2>(a, lds);
#endif
    }
}

extern "C" void kernel_launch(void* const* d_in, const int* in_sizes, int n_in, void* d_out, int out_size, void* d_ws, size_t ws_size, hipStream_t stream) {
    static int grid = 0;
    if (grid == 0) {
        if (n_in != 21 || out_size != NTOK * DM || ws_size < WS_END) { fprintf(stderr, "kernel_launch: unexpected shapes (n_in %d out %d ws %zu need %zu)\n", n_in, out_size, ws_size, (size_t)WS_END); grid = -1; return; }
        int dev = 0, cus = 0, per_cu = 0;
        hipGetDevice(&dev); hipDeviceGetAttribute(&cus, hipDeviceAttributeMultiprocessorCount, dev);
        if (hipFuncSetAttribute((const void*)mk_fwd, hipFuncAttributeMaxDynamicSharedMemorySize, LDS_BYTES) != hipSuccess) { fprintf(stderr, "kernel_launch: hipFuncSetAttribute failed\n"); grid = -1; return; }
        hipOccupancyMaxActiveBlocksPerMultiprocessor(&per_cu, (const void*)mk_fwd, 512, LDS_BYTES);
        if (per_cu < 1) { fprintf(stderr, "kernel_launch: occupancy query says %d blocks/CU\n", per_cu); per_cu = 1; }
        (void)hipGetLastError();
        grid = cus;
    }
    if (grid < 0) return;
    Args a{};
    for (int i = 0; i < 21; ++i) a.in[i] = (const float*)d_in[i];
    a.out = (float*)d_out; a.ws = (unsigned char*)d_ws;
#if MK_SPLIT
    for (int ph = 0; ph < NPHASE; ++ph) { a.ph_lo = ph; a.ph_hi = ph + 1; void* args[] = {&a};
        hipLaunchCooperativeKernel((const void*)mk_fwd, dim3(grid), dim3(512), args, LDS_BYTES, stream); }
#else
    a.ph_lo = 0; a.ph_hi = NPHASE;
    (void)hipMemsetAsync(d_ws, 0, 16384, stream);
    void* args[] = {&a};
    hipError_t e = hipLaunchCooperativeKernel((const void*)mk_fwd, dim3(grid), dim3(512), args, LDS_BYTES, stream);
    if (e != hipSuccess) fprintf(stderr, "cooperative launch failed: %s (grid %d)\n", hipGetErrorString(e), grid);
#ifdef MK_EXTRA_PHASE
    { Args a2 = a; a2.ph_lo = MK_EXTRA_PHASE; a2.ph_hi = MK_EXTRA_PHASE + 1; void* args2[] = {&a2}; hipLaunchCooperativeKernel((const void*)mk_fwd, dim3(grid), dim3(512), args2, LDS_BYTES, stream); }
#endif
#endif
}
```

```cpp
#include <hip/hip_runtime.h>
#include <hip/hip_cooperative_groups.h>
#include <cstdio>
#include <cstdint>
namespace cg = cooperative_groups;

#define LAS __attribute__((address_space(3)))
typedef unsigned short bf16_t;
typedef short bf16x8 __attribute__((ext_vector_type(8)));
typedef short bf16x4 __attribute__((ext_vector_type(4)));
typedef float f32x2 __attribute__((ext_vector_type(2)));
typedef float f32x4 __attribute__((ext_vector_type(4)));
typedef float f32x16 __attribute__((ext_vector_type(16)));
typedef unsigned u32x2 __attribute__((ext_vector_type(2)));
typedef unsigned u32x4 __attribute__((ext_vector_type(4)));

constexpr int NTOK = 16384, SEQ = 4096, DM = 2048, DFF = 5632, DIN = 6680;
constexpr int PROJ_LD = 3328;
constexpr int PROJT_ROWS = 512;
constexpr int WIN_NORMAL = 5376;
constexpr int WINT_ROWS = 6912;
constexpr int PC_RG = 0, PC_NQ = 1024, PC_KC = 2048, PC_VC = 2304, PC_KS = 2560, PC_KW = 2816, PC_GATE = 3072;
constexpr int PT_VS = 0, PT_VW = 256;

constexpr size_t WS_W13T = 16384;
constexpr size_t WS_W2T = WS_W13T + (size_t)11264 * 2048 * 2;
constexpr size_t WS_WINT = WS_W2T + (size_t)2048 * 5632 * 2;
constexpr size_t WS_WOUTT = WS_WINT + (size_t)WINT_ROWS * 2048 * 2;
constexpr size_t WS_CW1KT = WS_WOUTT + (size_t)2048 * 2048 * 2;
constexpr size_t WS_CW1VT = WS_CW1KT + (size_t)128 * 4096 * 2;
constexpr size_t WS_CW2KT = WS_CW1VT + (size_t)128 * 4096 * 2;
constexpr size_t WS_CW2VT = WS_CW2KT + (size_t)128 * 128 * 2;
constexpr size_t WS_CVEC = WS_CW2VT + (size_t)128 * 128 * 2;
constexpr size_t WS_ROT = WS_CVEC + 4096;
constexpr size_t WS_ROTT = WS_ROT + (size_t)2 * 4096 * 128 * 4;
constexpr size_t WS_XN = WS_ROTT + (size_t)2 * 4096 * 128 * 4;
constexpr size_t WS_BIG = WS_XN + (size_t)NTOK * DM * 2;
constexpr size_t WS_PROJT = WS_BIG + (size_t)NTOK * PROJ_LD * 2;
constexpr size_t WS_KSF = WS_PROJT;
constexpr size_t WS_KWF = WS_KSF + (size_t)8 * 64 * 16384;
constexpr size_t WS_VSF = WS_KWF + (size_t)8 * 64 * 16384;
constexpr size_t WS_VWF = WS_VSF + (size_t)8 * 64 * 16384;
constexpr size_t WS_QF = WS_VWF + (size_t)8 * 64 * 16384;
constexpr size_t WS_KF = WS_QF + (size_t)NTOK * 1024 * 2;
constexpr size_t WS_KTF = WS_KF + (size_t)NTOK * 1024 * 2;
constexpr size_t WS_VTF = WS_KTF + (size_t)NTOK * 1024 * 2;
constexpr size_t WS_UT = WS_VTF + (size_t)NTOK * 1024 * 2;
constexpr size_t WS_KCMP = WS_UT + (size_t)512 * 65536 * 2;
constexpr size_t WS_VCMPT = WS_KCMP + (size_t)8 * 256 * 128 * 2;
constexpr size_t WS_SSQ = WS_VCMPT + (size_t)8 * 256 * 128 * 2;
constexpr size_t WS_END = WS_SSQ + (size_t)3 * NTOK * 4;
static_assert(WS_BIG + (size_t)NTOK * DFF * 2 <= WS_UT, "ACT overlays PROJ/PROJT");

typedef __bf16 bf16x2_t __attribute__((ext_vector_type(2)));
__device__ __forceinline__ unsigned cvt_pk_bf16(float lo, float hi) { const f32x2 v = {lo, hi}; return __builtin_bit_cast(unsigned, __builtin_convertvector(v, bf16x2_t)); }
__device__ __forceinline__ int opaque_i(int v) { asm volatile("" : "+v"(v)); return v; }
__device__ __forceinline__ float bf2f(unsigned short h) { return __builtin_bit_cast(float, (unsigned)h << 16); }
__device__ __forceinline__ float bflo(unsigned u) { return __builtin_bit_cast(float, u << 16); }
__device__ __forceinline__ float bfhi(unsigned u) { return __builtin_bit_cast(float, u & 0xffff0000u); }
__device__ __forceinline__ float fast_rcp(float x) { return __builtin_amdgcn_rcpf(x); }
__device__ __forceinline__ float silu_f(float v) { return v * fast_rcp(1.0f + __expf(-v)); }
__device__ __forceinline__ float sigmoid_f(float v) { return fast_rcp(1.0f + __expf(-v)); }

namespace pg8 {
constexpr int BM = 256, BK = 64, HALF = 128, HTB = HALF * BK * 2, STAGE_BYTES = 8 * HTB, NXCD = 8, WGM = 4;
__host__ __device__ __forceinline__ int lds_byte(int r, int c) { const int st = (r >> 4) * 2 + (c >> 5), rr = r & 15, cc = c & 31, ob = rr * 64 + cc * 2; return st * 1024 + (ob ^ (((ob >> 9) & 1) << 5)); }
__host__ __device__ __forceinline__ void stage_rc(int b, int& R, int& C) { const int st = b / 1024, sb = b % 1024, swz = sb ^ (((sb >> 9) & 1) << 5); R = (st >> 1) * 16 + swz / 64; C = (st & 1) * 32 + (swz % 64) / 2; }
__host__ __device__ __forceinline__ int perm32(int rho) { const int n = rho >> 4, i = rho & 15; return 8 * (i >> 2) + 4 * n + (i & 3); }

struct Unit { int pm, pn, kind; };
__device__ __forceinline__ void map_unit(int wgid, int nM, int nN, int& pm, int& pn) {
    const int nwg = nM * nN;
    { const int q = nwg / NXCD, r = nwg % NXCD, xcd = wgid % NXCD, off = wgid / NXCD; wgid = (xcd < r ? xcd * (q + 1) : r * (q + 1) + (xcd - r) * q) + off; }
    const int nig = WGM * nN, gid = wgid / nig, fm = gid * WGM, gsz = (nM - fm) < WGM ? (nM - fm) : WGM;
    pm = fm + ((wgid % nig) % gsz); pn = (wgid % nig) / gsz;
}
struct StaticOrder {
    const char* A; const char* Bt; int nM, nN, nwg, G, c; size_t tstep;
    __device__ void init(const void* A_, const void* Bt_, int M, int N, int K, int G_, int c_) { A = (const char*)A_; Bt = (const char*)Bt_; nM = M / BM; nN = N / BM; nwg = nM * nN; G = G_; c = c_; tstep = (size_t)BM * K * 2; }
    __device__ __forceinline__ bool next(int i, Unit& u) const { const int L = i * G + c; if (L >= nwg) return false; map_unit(L, nM, nN, u.pm, u.pn); u.kind = 0; return true; }
    __device__ __forceinline__ void ptrs(const Unit& u, const char*& a, const char*& b) const { a = A + (size_t)u.pm * tstep; b = Bt + (size_t)u.pn * tstep; }
};

template <class Epi, class Sched>
__device__ __forceinline__ void gemm_phase(LAS unsigned char* lds, const int K, const Sched& S, const Epi& E) {
    const int tid = threadIdx.x, wid = __builtin_amdgcn_readfirstlane(tid >> 6), lane = tid & 63, wr = wid >> 2, wc = wid & 3, fr = lane & 15, fq = lane >> 4;
    const int nt = K / BK;
    unsigned voffA[2], voffB[2];
#pragma unroll
    for (int i = 0; i < 2; ++i) { int R, C; stage_rc(tid * 16 + i * 8192, R, C); const int Rb = (R & ~31) + perm32(R & 31);
        voffA[i] = (unsigned)(R * K + C) * 2u; voffB[i] = (unsigned)(Rb * K + C) * 2u; }
    const size_t kstep = (size_t)(BK * 2);
    const size_t hstep = (size_t)HALF * K * 2;
    const unsigned ldsw = (unsigned)wid * 1024u;
    const int aoff = lds_byte(wr * 64 + fr, fq * 8), boff = lds_byte(wc * 32 + fr, fq * 8);
#define PG8_SA(b, h) (((b) * 2 + (h)) * HTB)
#define PG8_SB(b, h) ((4 + (b) * 2 + (h)) * HTB)
#define PG8_STAGE(bufoff, gbase, voff) do { _Pragma("unroll") for (int _i = 0; _i < 2; ++_i) \
        __builtin_amdgcn_global_load_lds((const unsigned*)((const char*)(gbase) + (voff)[_i]), (LAS unsigned*)(lds + (bufoff) + ldsw + _i * 8192), 16, 0, 0); } while (0)
#define PG8_LDA(dst, b, h) do { _Pragma("unroll") for (int m = 0; m < 4; ++m) _Pragma("unroll") for (int k = 0; k < 2; ++k) dst[m][k] = *(const LAS bf16x8*)(lds + PG8_SA(b, h) + aoff + m * 2048 + k * 1024); } while (0)
#define PG8_LDB(dst, b, h) do { _Pragma("unroll") for (int n = 0; n < 2; ++n) _Pragma("unroll") for (int k = 0; k < 2; ++k) dst[n][k] = *(const LAS bf16x8*)(lds + PG8_SB(b, h) + boff + n * 2048 + k * 1024); } while (0)
#define PG8_MMA(ai, bj, At, Bt) do { __builtin_amdgcn_s_setprio(1); _Pragma("unroll") for (int m = 0; m < 4; ++m) _Pragma("unroll") for (int n = 0; n < 2; ++n) _Pragma("unroll") for (int k = 0; k < 2; ++k) \
        acc[ai][bj][m][n] = __builtin_amdgcn_mfma_f32_16x16x32_bf16(Bt[n][k], At[m][k], acc[ai][bj][m][n], 0, 0, 0); __builtin_amdgcn_s_setprio(0); } while (0)
#define PG8_WAIT_V(n) asm volatile("s_waitcnt vmcnt(" #n ")" ::: "memory")
#define PG8_WAIT_L(n) asm volatile("s_waitcnt lgkmcnt(" #n ")" ::: "memory")
#define PG8_BAR __builtin_amdgcn_s_barrier()
#define PG8_SCHED __builtin_amdgcn_sched_barrier(0)
    Unit cur, nxt; int ui = 0;
    if (!S.next(0, cur)) return;
    f32x4 acc[2][2][4][2];
#pragma unroll
    for (int a = 0; a < 2; ++a)
#pragma unroll
        for (int b = 0; b < 2; ++b)
#pragma unroll
            for (int m = 0; m < 4; ++m)
#pragma unroll
                for (int n = 0; n < 2; ++n) acc[a][b][m][n] = (f32x4){0.f, 0.f, 0.f, 0.f};
    bf16x8 At[4][2], B0[2][2], B1[2][2];
    const char* cA; const char* cB; S.ptrs(cur, cA, cB);
    PG8_STAGE(PG8_SB(0, 0), cB, voffB); PG8_STAGE(PG8_SB(0, 1), cB + hstep, voffB); PG8_STAGE(PG8_SA(0, 0), cA, voffA); PG8_STAGE(PG8_SA(0, 1), cA + hstep, voffA);
    if (wr == 1) PG8_BAR;
    PG8_WAIT_V(2); PG8_BAR;
    PG8_STAGE(PG8_SB(1, 0), cB + kstep, voffB); PG8_STAGE(PG8_SA(1, 0), cA + kstep, voffA); PG8_STAGE(PG8_SB(1, 1), cB + hstep + kstep, voffB);
    PG8_WAIT_V(6); PG8_BAR;
    for (;;) {
        const bool has_next = S.next(ui + 1, nxt);
        const char* nA = cA; const char* nB = cB; if (has_next) S.ptrs(nxt, nA, nB);
        for (int t = 0; t < nt; t += 2) {
            const bool last = (t == nt - 2);
            const char* a1 = cA + (size_t)(t + 1) * kstep;
            const char* a2 = last ? nA : cA + (size_t)(t + 2) * kstep; const char* b2 = last ? nB : cB + (size_t)(t + 2) * kstep;
            const char* a3 = a2 + kstep; const char* b3 = b2 + kstep;
            PG8_LDB(B0, 0, 0); PG8_LDB(B1, 0, 1); PG8_SCHED; PG8_LDA(At, 0, 0); PG8_STAGE(PG8_SA(1, 1), a1 + hstep, voffA);
            PG8_WAIT_V(8); PG8_WAIT_L(0); PG8_BAR; PG8_MMA(0, 0, At, B0); PG8_MMA(0, 1, At, B1); PG8_BAR; PG8_SCHED;
            PG8_LDA(At, 0, 1); PG8_STAGE(PG8_SB(0, 0), b2, voffB); PG8_STAGE(PG8_SB(0, 1), b2 + hstep, voffB); PG8_STAGE(PG8_SA(0, 0), a2, voffA);
            PG8_WAIT_V(8); PG8_WAIT_L(0); PG8_BAR; PG8_MMA(1, 0, At, B0); PG8_MMA(1, 1, At, B1); PG8_BAR; PG8_SCHED;
            PG8_LDB(B0, 1, 0); PG8_LDB(B1, 1, 1); PG8_SCHED; PG8_LDA(At, 1, 0); PG8_STAGE(PG8_SA(0, 1), a2 + hstep, voffA);
            PG8_WAIT_V(8); PG8_WAIT_L(0); PG8_BAR; PG8_MMA(0, 0, At, B0); PG8_MMA(0, 1, At, B1); PG8_BAR; PG8_SCHED;
            PG8_LDA(At, 1, 1); PG8_STAGE(PG8_SB(1, 0), b3, voffB); PG8_STAGE(PG8_SB(1, 1), b3 + hstep, voffB); PG8_STAGE(PG8_SA(1, 0), a3, voffA);
            PG8_WAIT_V(8); PG8_WAIT_L(0); PG8_BAR; PG8_MMA(1, 0, At, B0); PG8_MMA(1, 1, At, B1); PG8_BAR; PG8_SCHED;
        }
        if (wr == 0) PG8_BAR;
        E(acc, cur, wr, wc, fr, fq);
        if (!has_next) break;
#pragma unroll
        for (int a = 0; a < 2; ++a)
#pragma unroll
            for (int b = 0; b < 2; ++b)
#pragma unroll
                for (int m = 0; m < 4; ++m)
#pragma unroll
                    for (int n = 0; n < 2; ++n) acc[a][b][m][n] = (f32x4){0.f, 0.f, 0.f, 0.f};
        cur = nxt; cA = nA; cB = nB; ++ui;
        if (wr == 1) PG8_BAR;
    }
    PG8_WAIT_V(0);
    PG8_BAR;
#undef PG8_SA
#undef PG8_SB
#undef PG8_STAGE
#undef PG8_LDA
#undef PG8_LDB
#undef PG8_MMA
#undef PG8_WAIT_V
#undef PG8_WAIT_L
#undef PG8_BAR
#undef PG8_SCHED
}
}

using pg8::Unit;
struct EpiSwiglu {
    bf16_t* O; int ldc; const float* ssq;
    __device__ __forceinline__ void operator()(const f32x4 (&acc)[2][2][4][2], const Unit& u, int wr, int wc, int fr, int fq) const {
        const int row0 = u.pm * 256 + wr * 64 + fr, col0 = u.pn * 128 + wc * 32 + 8 * fq;
#pragma unroll
        for (int ai = 0; ai < 2; ++ai)
#pragma unroll
            for (int m = 0; m < 4; ++m) {
                bf16_t* rowp = O + (size_t)(row0 + ai * 128 + m * 16) * ldc + col0;
                const float rs = ssq ? rsqrtf(ssq[row0 + ai * 128 + m * 16] * (1.0f / DM) + 1e-6f) : 1.0f;
                float v[8];
#pragma unroll
                for (int n = 0; n < 2; ++n)
#pragma unroll
                    for (int j = 0; j < 4; ++j) v[n * 4 + j] = silu_f(acc[ai][0][m][n][j] * rs) * (acc[ai][1][m][n][j] * rs);
                u32x4 w; w.x = cvt_pk_bf16(v[0], v[1]); w.y = cvt_pk_bf16(v[2], v[3]); w.z = cvt_pk_bf16(v[4], v[5]); w.w = cvt_pk_bf16(v[6], v[7]);
                *(u32x4*)rowp = w;
            }
    }
};
struct EpiResid {
    const float* R; const bf16_t* Rb; float scale; bf16_t* Xb; float* ssq;
    __device__ __forceinline__ void operator()(const f32x4 (&acc)[2][2][4][2], const Unit& u, int wr, int wc, int fr_, int fq_) const {
        const int fr = opaque_i(fr_), fq = opaque_i(fq_);
        const int row0 = u.pm * 256 + wr * 64 + fr, col0 = u.pn * 256 + wc * 32 + 8 * fq;
#pragma unroll
        for (int ai = 0; ai < 2; ++ai)
#pragma unroll
            for (int m = 0; m < 4; ++m) {
                const int row = row0 + ai * 128 + m * 16; float sq = 0.f;
#pragma unroll
                for (int bj = 0; bj < 2; ++bj) {
                    const size_t off = (size_t)row * DM + col0 + bj * 128;
                    f32x4 r0, r1;
                    if (R) { r0 = *(const f32x4*)(R + off); r1 = *(const f32x4*)(R + off + 4); }
                    else { const u32x4 rb = *(const u32x4*)(Rb + off); r0 = (f32x4){bflo(rb.x), bfhi(rb.x), bflo(rb.y), bfhi(rb.y)}; r1 = (f32x4){bflo(rb.z), bfhi(rb.z), bflo(rb.w), bfhi(rb.w)}; }
                    const f32x4 o0 = r0 + acc[ai][bj][m][0] * scale, o1 = r1 + acc[ai][bj][m][1] * scale;
                    sq += o0[0] * o0[0] + o0[1] * o0[1] + o0[2] * o0[2] + o0[3] * o0[3] + o1[0] * o1[0] + o1[1] * o1[1] + o1[2] * o1[2] + o1[3] * o1[3];
                    u32x4 w; w.x = cvt_pk_bf16(o0[0], o0[1]); w.y = cvt_pk_bf16(o0[2], o0[3]); w.z = cvt_pk_bf16(o1[0], o1[1]); w.w = cvt_pk_bf16(o1[2], o1[3]);
                    *(u32x4*)(Xb + off) = w;
                }
                sq += __shfl_xor(sq, 16); sq += __shfl_xor(sq, 32); if (fq == 0) atomicAdd(ssq + row, sq);
            }
    }
};
struct EpiProj {
    unsigned char* ws;
    __device__ __forceinline__ void operator()(const f32x4 (&acc)[2][2][4][2], const Unit& u, int wr, int wc, int fr_, int fq_) const {
        const int fr = opaque_i(fr_), fq = opaque_i(fq_);
        bf16_t* const P = (bf16_t*)(ws + WS_BIG); bf16_t* const KSF = (bf16_t*)(ws + WS_KSF); bf16_t* const KWF = (bf16_t*)(ws + WS_KWF); bf16_t* const VSF = (bf16_t*)(ws + WS_VSF); bf16_t* const VWF = (bf16_t*)(ws + WS_VWF);
        bf16_t* const QF = (bf16_t*)(ws + WS_QF); bf16_t* const KF = (bf16_t*)(ws + WS_KF); bf16_t* const KTF = (bf16_t*)(ws + WS_KTF); bf16_t* const VTF = (bf16_t*)(ws + WS_VTF);
        const float* const rot = (const float*)(ws + WS_ROT); const float* const rott = (const float*)(ws + WS_ROTT); const float* const ssq = (const float*)(ws + WS_SSQ);
        if (u.kind == 0) {
            const int row0 = u.pm * 256 + wr * 64 + fr;
            if (u.pn < 8) {
                const float sc0 = (u.pn >= 4) ? 0.0625f : 1.0f; bf16_t* dst = (u.pn >= 4) ? KF : QF; const int h = u.pn & 3;
#pragma unroll
                for (int ai = 0; ai < 2; ++ai) {
                    f32x4 cc[4][2], ss[4][2]; float scv[4];
#pragma unroll
                    for (int m = 0; m < 4; ++m) {
                        const int row = row0 + ai * 128 + m * 16; const int pos = row & (SEQ - 1);
                        scv[m] = ssq[row];
#pragma unroll
                        for (int n = 0; n < 2; ++n) { const int dd = wc * 32 + 8 * fq + 4 * n;
                            cc[m][n] = *(const f32x4*)(rot + (size_t)pos * 128 + dd); ss[m][n] = *(const f32x4*)(rot + (size_t)SEQ * 128 + (size_t)pos * 128 + dd); }
                    }
                    __builtin_amdgcn_sched_barrier(0);
#pragma unroll
                    for (int m = 0; m < 4; ++m) {
                        const int row = row0 + ai * 128 + m * 16; const int pos = row & (SEQ - 1), b = row >> 12;
                        const float sc = sc0 * rsqrtf(scv[m] * (1.0f / DM) + 1e-6f);
                        f32x4 o[2][2];
#pragma unroll
                        for (int n = 0; n < 2; ++n) {
                            const f32x4 x1 = acc[ai][0][m][n], x2 = acc[ai][1][m][n];
                            o[0][n] = (x1 * cc[m][n] - x2 * ss[m][n]) * sc; o[1][n] = (x1 * ss[m][n] + x2 * cc[m][n]) * sc;
                        }
#pragma unroll
                        for (int bj = 0; bj < 2; ++bj) {
                            u32x4 w; w.x = cvt_pk_bf16(o[bj][0][0], o[bj][0][1]); w.y = cvt_pk_bf16(o[bj][0][2], o[bj][0][3]); w.z = cvt_pk_bf16(o[bj][1][0], o[bj][1][1]); w.w = cvt_pk_bf16(o[bj][1][2], o[bj][1][3]);
                            const int ks = 8 * bj + 2 * wc + (fq >> 1), hi = fq & 1;
                            *(u32x4*)(dst + ((((size_t)(b * 4 + h) * 128 + (pos >> 5)) * 16 + ks) * 64 + hi * 32 + (pos & 31)) * 8) = w;
                        }
                    }
                }
            } else if (u.pn == 18 || u.pn == 19) {
                bf16_t* dst = (u.pn == 18) ? KSF : KWF;
#pragma unroll
                for (int ai = 0; ai < 2; ++ai)
#pragma unroll
                    for (int m = 0; m < 4; ++m) {
                        const int row = row0 + ai * 128 + m * 16; const int pos = row & (SEQ - 1), b = row >> 12;
                        const float rs = rsqrtf(ssq[row] * (1.0f / DM) + 1e-6f);
#pragma unroll
                        for (int bj = 0; bj < 2; ++bj) {
                            const f32x4 v0 = acc[ai][bj][m][0] * rs, v1 = acc[ai][bj][m][1] * rs;
                            u32x4 w; w.x = cvt_pk_bf16(v0[0], v0[1]); w.y = cvt_pk_bf16(v0[2], v0[3]); w.z = cvt_pk_bf16(v1[0], v1[1]); w.w = cvt_pk_bf16(v1[2], v1[3]);
                            const int ks = 2 * wc + (fq >> 1);
                            *(u32x4*)(dst + (((((size_t)(b * 2 + bj) * 64 + (pos >> 6)) * 2 + ((pos >> 5) & 1)) * 8 + ks) * 64 + (fq & 1) * 32 + (pos & 31)) * 8) = w;
                        }
                    }
            } else {
                const int col0 = (u.pn - 8) * 256 + wc * 32 + 8 * fq;
#pragma unroll
                for (int ai = 0; ai < 2; ++ai)
#pragma unroll
                    for (int m = 0; m < 4; ++m) {
                        const int row = row0 + ai * 128 + m * 16;
                        const float rs = rsqrtf(ssq[row] * (1.0f / DM) + 1e-6f);
#pragma unroll
                        for (int bj = 0; bj < 2; ++bj) {
                            const f32x4 v0 = acc[ai][bj][m][0] * rs, v1 = acc[ai][bj][m][1] * rs;
                            u32x4 w; w.x = cvt_pk_bf16(v0[0], v0[1]); w.y = cvt_pk_bf16(v0[2], v0[3]); w.z = cvt_pk_bf16(v1[0], v1[1]); w.w = cvt_pk_bf16(v1[2], v1[3]);
                            *(u32x4*)(P + (size_t)row * PROJ_LD + col0 + bj * 128) = w;
                        }
                    }
            }
        } else {
            if (u.pm == 4 || u.pm == 5) {
                bf16_t* dst = (u.pm == 4) ? VSF : VWF; const int b = u.pn >> 4;
#pragma unroll
                for (int ai = 0; ai < 2; ++ai)
#pragma unroll
                    for (int m = 0; m < 4; ++m)
#pragma unroll
                        for (int bj = 0; bj < 2; ++bj) {
                            const int tj = 4 * (u.pn & 15) + 2 * bj + (wc >> 1), dt = 2 * wr + (m >> 1), r32 = 16 * (m & 1) + fr, st = 2 * (wc & 1) + (fq >> 1);
                            bf16_t* fp = dst + (((((size_t)(b * 2 + ai) * 64 + tj) * 4 + dt) * 4 + st) * 64 + r32) * 8 + 4 * (fq & 1);
#pragma unroll
                            for (int n = 0; n < 2; ++n) { const f32x4 q4 = *(const f32x4*)(ssq + u.pn * 256 + bj * 128 + wc * 32 + 8 * fq + 4 * n) * (1.0f / DM) + 1e-6f;
                                const f32x4 v = acc[ai][bj][m][n] * (f32x4){rsqrtf(q4[0]), rsqrtf(q4[1]), rsqrtf(q4[2]), rsqrtf(q4[3])}; u32x2 w; w.x = cvt_pk_bf16(v[0], v[1]); w.y = cvt_pk_bf16(v[2], v[3]); *(u32x2*)(fp + n * 32 * 8) = w; }
                        }
            } else {
                const bool rotate = u.pm >= 6; const int h = rotate ? u.pm - 6 : u.pm; bf16_t* dst = rotate ? KTF : VTF;
                const int b = u.pn >> 4;
#pragma unroll
                for (int m = 0; m < 4; ++m) {
                    const int dd = wr * 64 + m * 16 + fr;
#pragma unroll
                    for (int bj = 0; bj < 2; ++bj) {
                        const int chunk = 2 * (u.pn & 15) + bj;
                        f32x4 o[2][2]; f32x4 qv[2], cv[2], sv[2];
#pragma unroll
                        for (int n = 0; n < 2; ++n) {
                            const int pos = chunk * 128 + wc * 32 + 8 * fq + 4 * n;
                            qv[n] = *(const f32x4*)(ssq + u.pn * 256 + bj * 128 + wc * 32 + 8 * fq + 4 * n);
                            if (rotate) { cv[n] = *(const f32x4*)(rott + (size_t)dd * SEQ + pos); sv[n] = *(const f32x4*)(rott + (size_t)128 * SEQ + (size_t)dd * SEQ + pos); }
                        }
                        __builtin_amdgcn_sched_barrier(0);
#pragma unroll
                        for (int n = 0; n < 2; ++n) {
                            const f32x4 q4 = qv[n] * (1.0f / DM) + 1e-6f;
                            const f32x4 rs4 = (f32x4){rsqrtf(q4[0]), rsqrtf(q4[1]), rsqrtf(q4[2]), rsqrtf(q4[3])};
                            if (rotate) {
                                const f32x4 x1 = acc[0][bj][m][n] * rs4, x2 = acc[1][bj][m][n] * rs4;
                                o[0][n] = (x1 * cv[n] - x2 * sv[n]) * 0.0625f; o[1][n] = (x1 * sv[n] + x2 * cv[n]) * 0.0625f;
                            } else { o[0][n] = acc[0][bj][m][n] * rs4; o[1][n] = acc[1][bj][m][n] * rs4; }
                        }
#pragma unroll
                        for (int ai = 0; ai < 2; ++ai) {
                            const int rtile = 4 * ai + 2 * wr + (m >> 1), r32 = 16 * (m & 1) + fr, st = 2 * wc + (fq >> 1);
                            bf16_t* fp = dst + (((((size_t)(b * 4 + h) * 32 + chunk) * 8 + rtile) * 8 + st) * 64 + r32) * 8 + 4 * (fq & 1);
#pragma unroll
                            for (int n = 0; n < 2; ++n) { u32x2 w; w.x = cvt_pk_bf16(o[ai][n][0], o[ai][n][1]); w.y = cvt_pk_bf16(o[ai][n][2], o[ai][n][3]); *(u32x2*)(fp + n * 32 * 8) = w; }
                        }
                    }
                }
            }
        }
    }
};
struct WinOrder {
    const char* XN; const char* WT; int G, c; size_t tstep;
    __device__ __forceinline__ bool next(int i, Unit& u) const {
        const int L = i * G + c;
        if (L < 64 * 21) { pg8::map_unit(L, 64, 21, u.pm, u.pn); u.kind = 0; return true; }
        if (L < 64 * 21 + 384) { pg8::map_unit(L - 64 * 21, 6, 64, u.pm, u.pn); u.kind = 1; return true; }
        return false;
    }
    __device__ __forceinline__ void ptrs(const Unit& u, const char*& a, const char*& b) const {
        if (u.kind == 0) { a = XN + (size_t)u.pm * tstep; b = WT + (size_t)u.pn * tstep; }
        else { const int wrow = u.pm < 6 ? (WIN_NORMAL / 256 + u.pm) : (4 + (u.pm - 6)); a = WT + (size_t)wrow * tstep; b = XN + (size_t)u.pn * tstep; }
    }
};

__device__ __forceinline__ float wave_sum(float v) {
#pragma unroll
    for (int o = 32; o >= 1; o >>= 1) v += __shfl_xor(v, o);
    return v;
}
__device__ __forceinline__ int winmap(int n0) {
    if (n0 < 1024) return n0;
    if (n0 < 2048) return n0;
    if (n0 < 3072) return WIN_NORMAL + (n0 - 2048);
    if (n0 < 4096) return 2048 + PC_RG + (n0 - 3072);
    if (n0 < 5120) return 2048 + PC_NQ + (n0 - 4096);
    if (n0 < 5376) return 2048 + PC_KC + (n0 - 5120);
    if (n0 < 5632) return 2048 + PC_VC + (n0 - 5376);
    if (n0 < 5888) return 2048 + PC_KS + (n0 - 5632);
    if (n0 < 6144) return WIN_NORMAL + 1024 + (n0 - 5888);
    if (n0 < 6400) return 2048 + PC_KW + (n0 - 6144);
    if (n0 < 6656) return WIN_NORMAL + 1280 + (n0 - 6400);
    return 2048 + PC_GATE + (n0 - 6656);
}
__device__ __forceinline__ int drow_of(int kind, int n) {
    if (kind == 0) return n;
    if (kind == 1) return 256 * (n >> 7) + (n & 127);
    if (kind == 2) return 256 * (n >> 7) + 128 + (n & 127);
    return winmap(n & ~63) + (n & 63);
}
struct WItem { const float* src; bf16_t* dst; const float* gk; int ld, ncols, k0, n0, Kd, kind; };
template <bool NT = false>
__device__ __forceinline__ void wconv_load(const WItem& t, f32x4 (&v)[8]) {
    const int tid = threadIdx.x;
#pragma unroll
    for (int i = 0; i < 8; ++i) {
        const int idx = tid + i * 512, kk = idx >> 6, c4 = (idx & 63) * 4;
        v[i] = (f32x4){0.f, 0.f, 0.f, 0.f};
        if (t.n0 + c4 + 3 < t.ncols) { const f32x4* sp = (const f32x4*)(t.src + (size_t)(t.k0 + kk) * t.ld + t.n0 + c4); v[i] = NT ? __builtin_nontemporal_load(sp) : *sp; }
        if (t.gk) v[i] = v[i] * t.gk[t.k0 + kk];
    }
}
__device__ __forceinline__ void wconv_commit(const f32x4 (&v)[8], LAS float* tile) {
    const int tid = threadIdx.x;
#pragma unroll
    for (int i = 0; i < 8; ++i) {
        const int idx = tid + i * 512, kk = idx >> 6, c4 = (idx & 63) * 4;
        tile[kk * 257 + c4 + 0] = v[i][0]; tile[kk * 257 + c4 + 1] = v[i][1]; tile[kk * 257 + c4 + 2] = v[i][2]; tile[kk * 257 + c4 + 3] = v[i][3];
    }
}
template <bool NT = false>
__device__ __forceinline__ void wconv_drain(const WItem& t, LAS float* tile) {
    const int tid = threadIdx.x;
#pragma unroll
    for (int j = 0; j < 4; ++j) {
        const int n = (tid >> 3) + 64 * j, kc = (tid & 7) * 8;
        if (t.n0 + n < t.ncols) {
            float x[8];
#pragma unroll
            for (int q = 0; q < 8; ++q) x[q] = tile[(kc + q) * 257 + n];
            u32x4 w; w.x = cvt_pk_bf16(x[0], x[1]); w.y = cvt_pk_bf16(x[2], x[3]); w.z = cvt_pk_bf16(x[4], x[5]); w.w = cvt_pk_bf16(x[6], x[7]);
            if (t.kind == 4) { const int k = t.k0 + kc; *(u32x4*)(t.dst + ((((size_t)(n >> 5) * 256 + (k >> 4)) * 64 + ((k >> 3) & 1) * 32 + (n & 31)) * 8)) = w; }
            else { u32x4* dp = (u32x4*)(t.dst + (size_t)drow_of(t.kind, t.n0 + n) * t.Kd + t.k0 + kc); if (NT) __builtin_nontemporal_store(w, dp); else *dp = w; }
        }
    }
}
__device__ __forceinline__ WItem ffn_witem(int it, const float* w1, const float* w3, const float* w2, unsigned char* ws, const float* g13) {
    WItem t; t.gk = nullptr;
    if (it < 1408) { const bool is3 = it >= 704; const int r = is3 ? it - 704 : it; const int kt = r / 22, nt = r % 22;
        t.gk = g13; t.src = is3 ? w3 : w1; t.dst = (bf16_t*)(ws + WS_W13T); t.ld = DFF; t.ncols = DFF; t.k0 = kt * 64; t.n0 = nt * 256; t.Kd = DM; t.kind = is3 ? 2 : 1; }
    else { const int r = it - 1408, kt = r >> 3, nt = r & 7;
        t.src = w2; t.dst = (bf16_t*)(ws + WS_W2T); t.ld = DM; t.ncols = DM; t.k0 = kt * 64; t.n0 = nt * 256; t.Kd = DFF; t.kind = 0; }
    return t;
}
__device__ __forceinline__ WItem p0_witem(int it, const float* const* in, unsigned char* ws) {
    if (it < 2112) return ffn_witem(it, in[2], in[3], in[4], ws, nullptr);
    WItem t; t.kind = 0; t.gk = nullptr;
    if (it < 2976) { const int r = it - 2112, kt = r / 27, nt = r % 27; t.gk = in[5]; t.src = in[6]; t.dst = (bf16_t*)(ws + WS_WINT); t.ld = DIN; t.ncols = DIN; t.k0 = kt * 64; t.n0 = nt * 256; t.Kd = DM; t.kind = 3; }
    else if (it < 3232) { const int r = it - 2976, kt = r >> 3, nt = r & 7; t.src = in[14]; t.dst = (bf16_t*)(ws + WS_WOUTT); t.ld = DM; t.ncols = DM; t.k0 = kt * 64; t.n0 = nt * 256; t.Kd = DM; }
    else if (it < 3296) { const int r = it - 3232; t.src = in[9]; t.dst = (bf16_t*)(ws + WS_CW1KT); t.ld = 128; t.ncols = 128; t.k0 = r * 64; t.n0 = 0; t.Kd = 4096; t.kind = 4; }
    else if (it < 3360) { const int r = it - 3296; t.src = in[12]; t.dst = (bf16_t*)(ws + WS_CW1VT); t.ld = 128; t.ncols = 128; t.k0 = r * 64; t.n0 = 0; t.Kd = 4096; t.kind = 4; }
    else if (it < 3362) { const int r = it - 3360; t.src = in[10]; t.dst = (bf16_t*)(ws + WS_CW2KT); t.ld = 128; t.ncols = 128; t.k0 = r * 64; t.n0 = 0; t.Kd = 128; }
    else { const int r = it - 3362; t.src = in[13]; t.dst = (bf16_t*)(ws + WS_CW2VT); t.ld = 128; t.ncols = 128; t.k0 = r * 64; t.n0 = 0; t.Kd = 128; }
    return t;
}
__device__ __forceinline__ void rms_rows_bf16(const float* __restrict__ X, const float* __restrict__ g, bf16_t* __restrict__ out) {
    const int tx = opaque_i(threadIdx.x); const int lane = tx & 63, gw = blockIdx.x * 8 + (tx >> 6), nw = gridDim.x * 8;
    for (int row = gw; row < NTOK; row += nw) {
        const float* xr = X + (size_t)row * DM; f32x4 v[8]; float ss = 0.f;
#pragma unroll
        for (int i = 0; i < 8; ++i) { v[i] = *(const f32x4*)(xr + (i * 64 + lane) * 4); ss += v[i][0] * v[i][0] + v[i][1] * v[i][1] + v[i][2] * v[i][2] + v[i][3] * v[i][3]; }
        ss = wave_sum(ss); const float rs = rsqrtf(ss * (1.0f / DM) + 1e-6f);
#pragma unroll
        for (int i = 0; i < 8; ++i) { const f32x4 gg = *(const f32x4*)(g + (i * 64 + lane) * 4); const f32x4 y = v[i] * rs * gg;
            u32x2 w; w.x = cvt_pk_bf16(y[0], y[1]); w.y = cvt_pk_bf16(y[2], y[3]); *(u32x2*)(out + (size_t)row * DM + (i * 64 + lane) * 4) = w; }
    }
}
__device__ __forceinline__ void rms_final_from_bf16(const bf16_t* __restrict__ X, const float* __restrict__ ssq, const float* __restrict__ g, float* __restrict__ out) {
    const int tx = opaque_i(threadIdx.x); const int lane = tx & 63, gw = blockIdx.x * 8 + (tx >> 6), nw = gridDim.x * 8;
    for (int row = gw; row < NTOK; row += nw) {
        const float rs = rsqrtf(ssq[row] * (1.0f / DM) + 1e-6f);
#pragma unroll
        for (int i = 0; i < 4; ++i) {
            const int c = (i * 64 + lane) * 8;
            const u32x4 v = *(const u32x4*)(X + (size_t)row * DM + c);
            const f32x4 g0 = *(const f32x4*)(g + c), g1 = *(const f32x4*)(g + c + 4);
            f32x4 o0, o1;
            o0[0] = bflo(v.x) * rs * g0[0]; o0[1] = bfhi(v.x) * rs * g0[1]; o0[2] = bflo(v.y) * rs * g0[2]; o0[3] = bfhi(v.y) * rs * g0[3];
            o1[0] = bflo(v.z) * rs * g1[0]; o1[1] = bfhi(v.z) * rs * g1[1]; o1[2] = bflo(v.w) * rs * g1[2]; o1[3] = bfhi(v.w) * rs * g1[3];
            *(f32x4*)(out + (size_t)row * DM + c) = o0; *(f32x4*)(out + (size_t)row * DM + c + 4) = o1;
        }
    }
}
__device__ __forceinline__ void rms_rows_f32_inplace(float* __restrict__ X, const float* __restrict__ g) {
    const int tx = opaque_i(threadIdx.x); const int lane = tx & 63, gw = blockIdx.x * 8 + (tx >> 6), nw = gridDim.x * 8;
    for (int row = gw; row < NTOK; row += nw) {
        float* xr = X + (size_t)row * DM; f32x4 v[8]; float ss = 0.f;
#pragma unroll
        for (int i = 0; i < 8; ++i) { v[i] = *(const f32x4*)(xr + (i * 64 + lane) * 4); ss += v[i][0] * v[i][0] + v[i][1] * v[i][1] + v[i][2] * v[i][2] + v[i][3] * v[i][3]; }
        ss = wave_sum(ss); const float rs = rsqrtf(ss * (1.0f / DM) + 1e-6f);
#pragma unroll
        for (int i = 0; i < 8; ++i) { const f32x4 gg = *(const f32x4*)(g + (i * 64 + lane) * 4); *(f32x4*)(xr + (i * 64 + lane) * 4) = v[i] * rs * gg; }
    }
}
#define MK_SPLIT 0
#define MK_DO8 true
#define MK_REPEAT 0

struct Args { const float* in[21]; float* out; unsigned char* ws; int ph_lo, ph_hi; };
__device__ __forceinline__ f32x16 mfma32(bf16x8 a, bf16x8 b, f32x16 c) { return __builtin_amdgcn_mfma_f32_32x32x16_bf16(a, b, c, 0, 0, 0); }
__device__ __forceinline__ f32x16 zero16() { f32x16 z; for (int i = 0; i < 16; ++i) z[i] = 0.f; return z; }
__device__ __forceinline__ bf16x8 ld_frag(const bf16_t* p) { return *(const bf16x8*)p; }
__device__ __forceinline__ bf16x8 mk_frag(u32x2 lo, u32x2 hi) { u32x4 v; v.x = lo.x; v.y = lo.y; v.z = hi.x; v.w = hi.y; return __builtin_bit_cast(bf16x8, v); }
__device__ __forceinline__ bf16x8 pack8(const f32x16& p, int s) { u32x4 v; v.x = cvt_pk_bf16(p[8 * s + 0], p[8 * s + 1]); v.y = cvt_pk_bf16(p[8 * s + 2], p[8 * s + 3]); v.z = cvt_pk_bf16(p[8 * s + 4], p[8 * s + 5]); v.w = cvt_pk_bf16(p[8 * s + 6], p[8 * s + 7]); return __builtin_bit_cast(bf16x8, v); }
__device__ __forceinline__ float log2_gamma(int h) { return log2f(1.0f - exp2f(-5.0f - (float)h)); }


__device__ __forceinline__ void lds_dma_copy(LAS unsigned char* dst, const bf16_t* src, int nkb) {
    const int w = __builtin_amdgcn_readfirstlane(threadIdx.x >> 6), lane = threadIdx.x & 63;
    for (int c = w; c < nkb; c += 8)
        __builtin_amdgcn_global_load_lds((const unsigned*)(src + (size_t)c * 512 + lane * 8), (LAS unsigned*)(dst + c * 1024), 16, 0, 0);
}
__device__ __forceinline__ void dma_wait_barrier() { asm volatile("s_waitcnt vmcnt(0)" ::: "memory"); __syncthreads(); }

__device__ __forceinline__ void compress_item(const Args& a, LAS unsigned char* lds, int ci) {
    const int tid = opaque_i(threadIdx.x), w = tid >> 6, lane = tid & 63, r32 = lane & 31, hi = lane >> 5;
    const int kv = ci >> 6, rr = ci & 63, bg = rr >> 3, nt = rr & 7, b = bg >> 1, g = bg & 1;
    unsigned char* ws = a.ws;
    const bf16_t* PROJ = (const bf16_t*)(ws + WS_BIG);
    const bf16_t* W1T = (const bf16_t*)(ws + (kv ? WS_CW1VT : WS_CW1KT));
    const bf16_t* W2T = (const bf16_t*)(ws + (kv ? WS_CW2VT : WS_CW2KT));
    const float* pe = a.in[kv ? 11 : 8];
    const int colbase = (kv ? PC_VC : PC_KC) + g * 128;
    const int n = nt * 32 + r32, nc = n < 255 ? n : 254;
    f32x16 acc[4];
#pragma unroll
    for (int i = 0; i < 4; ++i) acc[i] = zero16();
    const int ws_ = __builtin_amdgcn_readfirstlane(w);
    for (int st = 0; st < 8; ++st) {
#pragma unroll
        for (int i = 0; i < 16; ++i) { const int c = ws_ * 16 + i, ft = c >> 5, j = c & 31;
            __builtin_amdgcn_global_load_lds((const unsigned*)(W1T + ((size_t)(ft * 256 + st * 32 + j) * 64 + lane) * 8), (LAS unsigned*)(lds + c * 1024), 16, 0, 0); }
        u32x4 av[4]; f32x4 p0[4], p1[4];
#pragma unroll
        for (int i = 0; i < 4; ++i) { const int pr = w + 8 * i, l = 4 * st + (pr >> 3), ks = pr & 7;
            av[i] = *(const u32x4*)(PROJ + (size_t)(b * SEQ + 16 * nc + l) * PROJ_LD + colbase + 8 * hi + 16 * ks);
            p0[i] = *(const f32x4*)(pe + l * 128 + 8 * hi + 16 * ks); p1[i] = *(const f32x4*)(pe + l * 128 + 8 * hi + 16 * ks + 4); }
        dma_wait_barrier();
#pragma unroll
        for (int i = 0; i < 4; ++i) { const int pr = w + 8 * i;
            u32x4 bv; bv.x = cvt_pk_bf16(bflo(av[i].x) + p0[i][0], bfhi(av[i].x) + p0[i][1]); bv.y = cvt_pk_bf16(bflo(av[i].y) + p0[i][2], bfhi(av[i].y) + p0[i][3]);
            bv.z = cvt_pk_bf16(bflo(av[i].z) + p1[i][0], bfhi(av[i].z) + p1[i][1]); bv.w = cvt_pk_bf16(bflo(av[i].w) + p1[i][2], bfhi(av[i].w) + p1[i][3]);
            const bf16x8 bfr = __builtin_bit_cast(bf16x8, bv);
#pragma unroll
            for (int ft = 0; ft < 4; ++ft) acc[ft] = mfma32(*(const LAS bf16x8*)(lds + (ft * 32 + pr) * 1024 + lane * 16), bfr, acc[ft]); }
        __syncthreads();
    }
    LAS float* part = (LAS float*)lds;
#pragma unroll
    for (int ft = 0; ft < 4; ++ft)
#pragma unroll
        for (int r = 0; r < 16; ++r) { const int f = 32 * ft + (r & 3) + 8 * (r >> 2) + 4 * hi; part[w * 4096 + f * 32 + r32] = acc[ft][r]; }
    __syncthreads();
    float hv[8];
    { const int nn = tid & 31, fg = tid >> 5;
#pragma unroll
      for (int j = 0; j < 8; ++j) { float s = 0.f;
#pragma unroll
          for (int ww = 0; ww < 8; ++ww) s += part[ww * 4096 + (8 * fg + j) * 32 + nn];
          hv[j] = silu_f(s); } }
    __syncthreads();
    LAS bf16_t* Hs = (LAS bf16_t*)lds;
    { const int nn = tid & 31, fg = tid >> 5; u32x4 v; v.x = cvt_pk_bf16(hv[0], hv[1]); v.y = cvt_pk_bf16(hv[2], hv[3]); v.z = cvt_pk_bf16(hv[4], hv[5]); v.w = cvt_pk_bf16(hv[6], hv[7]);
      *(LAS u32x4*)(Hs + nn * 136 + 8 * fg) = v; }
    __syncthreads();
    if (w < 4) {
        f32x16 o = zero16();
#pragma unroll
        for (int ks = 0; ks < 8; ++ks) {
            const bf16x8 af = ld_frag(W2T + (size_t)(32 * w + r32) * 128 + 16 * ks + 8 * hi);
            const bf16x8 bf = *(const LAS bf16x8*)(Hs + r32 * 136 + 16 * ks + 8 * hi);
            o = mfma32(af, bf, o);
        }
        const bool live = n < 255;
        if (kv == 0) {
            bf16_t* dst = (bf16_t*)(ws + WS_KCMP) + ((size_t)(bg * 4 + (nt >> 1)) * 2 + (nt & 1)) * 8 * 512;
#pragma unroll
            for (int q = 0; q < 4; ++q) { u32x2 v; v.x = live ? cvt_pk_bf16(o[4 * q], o[4 * q + 1]) : 0u; v.y = live ? cvt_pk_bf16(o[4 * q + 2], o[4 * q + 3]) : 0u;
                *(u32x2*)(dst + ((2 * w + (q >> 1)) * 64 + (q & 1) * 32 + r32) * 8 + 4 * hi) = v; }
        } else {
            const int st = 2 * (nt & 1) + (r32 >> 4), hh = (r32 >> 2) & 1, slot = 4 * ((r32 >> 3) & 1) + (r32 & 3);
            bf16_t* dst = (bf16_t*)(ws + WS_VCMPT) + ((((size_t)(bg * 4 + (nt >> 1)) * 4 + w) * 4 + st) * 64 + hh * 32) * 8 + slot;
#pragma unroll
            for (int r = 0; r < 16; ++r) { const int o32 = (r & 3) + 8 * (r >> 2) + 4 * hi; dst[o32 * 8] = live ? (bf16_t)(cvt_pk_bf16(o[r], 0.f) & 0xffffu) : (bf16_t)0; }
        }
    }
    __syncthreads();
}

__device__ __forceinline__ void ret_u_item(const Args& a, LAS unsigned char* lds, int ui) {
    const int tid = opaque_i(threadIdx.x), w = tid >> 6, lane = tid & 63, r32 = lane & 31, hi = lane >> 5;
    const int h = (ui >> 5) & 3, n = ui & 31, bh = ui >> 5;
    unsigned char* ws = a.ws;
    lds_dma_copy(lds, (const bf16_t*)(ws + WS_KF) + ((size_t)bh * 128 + n * 4) * 8192, 64);
    lds_dma_copy(lds + 65536, (const bf16_t*)(ws + WS_VTF) + (size_t)ui * 32768, 64);
    dma_wait_barrier();
    const LAS unsigned char* KFl = lds + lane * 16; const LAS unsigned char* VTF = lds + 65536 + lane * 16;
    const int dt0 = 4 * (w >> 2), et0 = 2 * (w & 3);
    const float l2g = log2_gamma(h);
    u32x4 i1, i2;
    { const int e1 = r32 - 8 * hi, e2 = r32 - 16 - 8 * hi; unsigned v1[4], v2[4];
#pragma unroll
      for (int q = 0; q < 4; ++q) { v1[q] = (e1 == 2 * q ? 0x3F80u : 0u) | (e1 == 2 * q + 1 ? 0x3F800000u : 0u); v2[q] = (e2 == 2 * q ? 0x3F80u : 0u) | (e2 == 2 * q + 1 ? 0x3F800000u : 0u); }
      i1.x = v1[0]; i1.y = v1[1]; i1.z = v1[2]; i1.w = v1[3]; i2.x = v2[0]; i2.y = v2[1]; i2.z = v2[2]; i2.w = v2[3]; }
    const bf16x8 id1 = __builtin_bit_cast(bf16x8, i1), id2 = __builtin_bit_cast(bf16x8, i2);
    f32x16 acc[4][2];
#pragma unroll
    for (int i = 0; i < 4; ++i) { acc[i][0] = zero16(); acc[i][1] = zero16(); }
#pragma unroll 1
    for (int mt = 0; mt < 4; ++mt) {
        bf16x8 bf[2][2];
#pragma unroll
        for (int s = 0; s < 2; ++s) {
            const int ks = 2 * mt + s; float z[8];
#pragma unroll
            for (int j = 0; j < 8; ++j) { const int m = 16 * ks + 8 * (j >> 2) + 4 * hi + (j & 3); z[j] = exp2f((float)(127 - m) * l2g); }
#pragma unroll
            for (int et = 0; et < 2; ++et) {
                const u32x4 v = *(const LAS u32x4*)(VTF + ((et0 + et) * 8 + ks) * 1024);
                u32x4 o; o.x = cvt_pk_bf16(bflo(v.x) * z[0], bfhi(v.x) * z[1]); o.y = cvt_pk_bf16(bflo(v.y) * z[2], bfhi(v.y) * z[3]);
                o.z = cvt_pk_bf16(bflo(v.z) * z[4], bfhi(v.z) * z[5]); o.w = cvt_pk_bf16(bflo(v.w) * z[6], bfhi(v.w) * z[7]);
                bf[s][et] = __builtin_bit_cast(bf16x8, o);
            }
        }
#pragma unroll
        for (int dt = 0; dt < 4; ++dt) {
            f32x16 X = zero16();
            X = mfma32(*(const LAS bf16x8*)(KFl + (mt * 16 + 2 * (dt0 + dt)) * 1024), id1, X);
            X = mfma32(*(const LAS bf16x8*)(KFl + (mt * 16 + 2 * (dt0 + dt) + 1) * 1024), id2, X);
#pragma unroll
            for (int s = 0; s < 2; ++s) {
                const bf16x8 af = pack8(X, s);
                acc[dt][0] = mfma32(af, bf[s][0], acc[dt][0]); acc[dt][1] = mfma32(af, bf[s][1], acc[dt][1]);
            }
        }
    }
    bf16_t* UT = (bf16_t*)(ws + WS_UT) + (size_t)ui * 65536;
#pragma unroll
    for (int dt = 0; dt < 4; ++dt)
#pragma unroll
        for (int et = 0; et < 2; ++et)
#pragma unroll
            for (int q = 0; q < 4; ++q) { u32x2 v; v.x = cvt_pk_bf16(acc[dt][et][4 * q], acc[dt][et][4 * q + 1]); v.y = cvt_pk_bf16(acc[dt][et][4 * q + 2], acc[dt][et][4 * q + 3]);
                const int ksd = 2 * (dt0 + dt) + (q >> 1);
                *(u32x2*)(UT + ((((et0 + et) * 16 + ksd) * 64 + (q & 1) * 32 + r32) * 8 + 4 * hi)) = v; }
    __syncthreads();
}

__device__ __forceinline__ void ret_scan(const Args& a) {
    bf16_t* UT = (bf16_t*)(a.ws + WS_UT);
    for (int gid = blockIdx.x * 512 + threadIdx.x; gid < 16 * 8192; gid += gridDim.x * 512) {
        const int bh = gid >> 13, off = (gid & 8191) * 8, h = bh & 3;
        const float dec = exp2f(128.0f * log2_gamma(h));
        float st[8];
#pragma unroll
        for (int j = 0; j < 8; ++j) st[j] = 0.f;
        bf16_t* p = UT + (size_t)bh * 32 * 65536 + off;
        for (int n = 0; n < 32; ++n) {
            const u32x4 u = *(const u32x4*)(p + (size_t)n * 65536);
            u32x4 o; o.x = cvt_pk_bf16(st[0], st[1]); o.y = cvt_pk_bf16(st[2], st[3]); o.z = cvt_pk_bf16(st[4], st[5]); o.w = cvt_pk_bf16(st[6], st[7]);
            *(u32x4*)(p + (size_t)n * 65536) = o;
            st[0] = st[0] * dec + bflo(u.x); st[1] = st[1] * dec + bfhi(u.x); st[2] = st[2] * dec + bflo(u.y); st[3] = st[3] * dec + bfhi(u.y);
            st[4] = st[4] * dec + bflo(u.z); st[5] = st[5] * dec + bfhi(u.z); st[6] = st[6] * dec + bflo(u.w); st[7] = st[7] * dec + bfhi(u.w);
        }
    }
}

__device__ __forceinline__ void ret_y_item(const Args& a, LAS unsigned char* lds, int ui) {
    const int tid = opaque_i(threadIdx.x), w = tid >> 6, lane = tid & 63, r32 = lane & 31, hi = lane >> 5;
    const int n = ui & 31, bh = ui >> 5, h = bh & 3, b = bh >> 2;
    unsigned char* ws = a.ws;
    const bf16_t* PROJ = (const bf16_t*)(ws + WS_BIG);
    const bf16_t* QF = (const bf16_t*)(ws + WS_QF) + (size_t)bh * 128 * 8192 + lane * 8;
    lds_dma_copy(lds, (const bf16_t*)(ws + WS_UT) + (size_t)ui * 65536, 128);
    const LAS unsigned char* RT = lds + lane * 16;
    const LAS unsigned char* KF = lds + lane * 16;
    const LAS unsigned char* VTF = lds + 65536 + lane * 16;
    const size_t tok0 = (size_t)b * SEQ + n * 128;
    const int ct = w & 3, eh = w >> 2, c = 32 * ct + r32;
    const float l2g = log2_gamma(h);
    bf16x8 qf[16];
#pragma unroll
    for (int ks = 0; ks < 16; ++ks) qf[ks] = ld_frag(QF + ((n * 4 + ct) * 16 + ks) * 512);
    f32x16 acc[4];
#pragma unroll
    for (int i = 0; i < 4; ++i) acc[i] = zero16();
    dma_wait_barrier();
    {
#pragma unroll
      for (int ks = 0; ks < 16; ++ks)
#pragma unroll
          for (int et = 0; et < 4; ++et) acc[et] = mfma32(*(const LAS bf16x8*)(RT + ((4 * eh + et) * 16 + ks) * 1024), qf[ks], acc[et]);
      const float xi = exp2f((float)(c + 1) * l2g);
#pragma unroll
      for (int et = 0; et < 4; ++et) acc[et] = acc[et] * xi; }
    __syncthreads();
    lds_dma_copy(lds, (const bf16_t*)(ws + WS_KF) + ((size_t)bh * 128 + n * 4) * 8192, 64);
    lds_dma_copy(lds + 65536, (const bf16_t*)(ws + WS_VTF) + (size_t)ui * 32768, 64);
    dma_wait_barrier();
    for (int mt = 0; mt <= ct; ++mt) {
        f32x16 s = zero16();
#pragma unroll
        for (int ks = 0; ks < 16; ++ks) s = mfma32(*(const LAS bf16x8*)(KF + (mt * 16 + ks) * 1024), qf[ks], s);
#pragma unroll
        for (int r = 0; r < 16; ++r) { const int m = 32 * mt + (r & 3) + 8 * (r >> 2) + 4 * hi; const int df = c - m; s[r] = df >= 0 ? s[r] * exp2f((float)df * l2g) : 0.f; }
#pragma unroll
        for (int s2 = 0; s2 < 2; ++s2) {
            const bf16x8 pf = pack8(s, s2);
#pragma unroll
            for (int et = 0; et < 4; ++et) acc[et] = mfma32(*(const LAS bf16x8*)(VTF + ((4 * eh + et) * 8 + 2 * mt + s2) * 1024), pf, acc[et]);
        }
    }
    float s1 = 0.f, s2 = 0.f;
#pragma unroll
    for (int et = 0; et < 4; ++et)
#pragma unroll
        for (int r = 0; r < 16; ++r) { s1 += acc[et][r]; s2 += acc[et][r] * acc[et][r]; }
    s1 += __shfl_xor(s1, 32); s2 += __shfl_xor(s2, 32);
    LAS float* st = (LAS float*)(lds + 131072);
    if (hi == 0) { st[(eh * 128 + c) * 2] = s1; st[(eh * 128 + c) * 2 + 1] = s2; }
    __syncthreads();
    const float t1 = st[c * 2] + st[(128 + c) * 2], t2 = st[c * 2 + 1] + st[(128 + c) * 2 + 1];
    const float mu = t1 * (1.0f / 256.0f), var = fmaxf(t2 * (1.0f / 256.0f) - mu * mu, 0.f), rstd = rsqrtf(var + 1e-6f);
    const float* gain = a.in[7] + h * 256;
    const bf16_t* grow = PROJ + (tok0 + c) * PROJ_LD + PC_RG + h * 256;
    bf16_t* yrow = (bf16_t*)(ws + WS_XN) + (tok0 + c) * DM + h * 256;
    u32x2 gv[4][4];
#pragma unroll
    for (int et = 0; et < 4; ++et)
#pragma unroll
        for (int q = 0; q < 4; ++q) gv[et][q] = *(const u32x2*)(grow + 128 * eh + 32 * et + 8 * q + 4 * hi);
    __builtin_amdgcn_sched_barrier(0);
#pragma unroll
    for (int et = 0; et < 4; ++et) {
        f32x4 gn[4];
#pragma unroll
        for (int q = 0; q < 4; ++q) gn[q] = *(const f32x4*)(gain + 128 * eh + 32 * et + 8 * q + 4 * hi);
#pragma unroll
        for (int q = 0; q < 4; ++q) {
            const int e = 128 * eh + 32 * et + 8 * q + 4 * hi;
            const float y0 = (acc[et][4 * q] - mu) * rstd * gn[q][0] * silu_f(bflo(gv[et][q].x)), y1 = (acc[et][4 * q + 1] - mu) * rstd * gn[q][1] * silu_f(bfhi(gv[et][q].x));
            const float y2 = (acc[et][4 * q + 2] - mu) * rstd * gn[q][2] * silu_f(bflo(gv[et][q].y)), y3 = (acc[et][4 * q + 3] - mu) * rstd * gn[q][3] * silu_f(bfhi(gv[et][q].y));
            u32x2 o; o.x = cvt_pk_bf16(y0, y1); o.y = cvt_pk_bf16(y2, y3);
            *(u32x2*)(yrow + e) = o;
        }
    }
    __syncthreads();
}

constexpr int NSA_KB = 0, NSA_VB = 49152, NSA_BIAS = 98304, NSA_IMPA = NSA_BIAS + 2112, NSA_IMPB = NSA_IMPA + 8 * 8 * 66 * 4, NSA_SELM = NSA_IMPB + 8 * 8 * 66 * 4, NSA_LIST = NSA_SELM + 512, NSA_END = NSA_LIST + 4 * 160;
static_assert(NSA_END <= 147456 - 64, "NSA LDS map");
constexpr float LOG2E = 1.4426950408889634f;
__device__ __forceinline__ int t5_bucket_dev(int n) {
    if (n < 16) return n;
    const float v = logf((float)n / 16.0f) / 2.0794415416798357f * 16.0f;
    const int l = 16 + (int)v; return l < 31 ? l : 31;
}
struct TileSrc { const bf16_t* k; const bf16_t* v; };
__device__ __forceinline__ TileSrc nsa_src(unsigned char* ws, int mode, int idx, int b, int g) {
    TileSrc s; const int bg = b * 2 + g;
    if (mode <= 1) { s.k = (const bf16_t*)(ws + WS_KCMP) + (size_t)(bg * 4 + idx) * 8192; s.v = (const bf16_t*)(ws + WS_VCMPT) + (size_t)(bg * 4 + idx) * 8192; }
    else if (mode == 2) { s.k = (const bf16_t*)(ws + WS_KWF) + (size_t)(bg * 64 + idx) * 8192; s.v = (const bf16_t*)(ws + WS_VWF) + (size_t)(bg * 64 + idx) * 8192; }
    else { s.k = (const bf16_t*)(ws + WS_KSF) + (size_t)(bg * 64 + idx) * 8192; s.v = (const bf16_t*)(ws + WS_VSF) + (size_t)(bg * 64 + idx) * 8192; }
    return s;
}
__device__ __forceinline__ void nsa_fill(LAS unsigned char* lds, int buf, const TileSrc& s) {
    const int tx = opaque_i(threadIdx.x); const int w = __builtin_amdgcn_readfirstlane(tx >> 6), lane = tx & 63;
#pragma unroll
    for (int i = 0; i < 2; ++i) {
        const int c = w * 2 + i;
        __builtin_amdgcn_global_load_lds((const unsigned*)(s.k + c * 512 + lane * 8), (LAS unsigned*)(lds + NSA_KB + buf * 16384 + c * 1024), 16, 0, 0);
        __builtin_amdgcn_global_load_lds((const unsigned*)(s.v + c * 512 + lane * 8), (LAS unsigned*)(lds + NSA_VB + buf * 16384 + c * 1024), 16, 0, 0);
    }
}
__device__ __forceinline__ float max_xor32(float x) {
    float a = x, b = x;
    asm volatile("s_nop 1\n\tv_permlane32_swap_b32 %0, %1\n\ts_nop 1" : "+v"(a), "+v"(b));
    return fmaxf(a, b);
}
__device__ __forceinline__ void nsa_qk(LAS unsigned char* lds, int buf, int lane_in, const bf16x8 (&qf)[8], f32x16 (&s)[2]) {
    const int lane = opaque_i(lane_in); const int r32 = lane & 31, hi = lane >> 5;
#pragma unroll
    for (int kt = 0; kt < 2; ++kt) { s[kt] = zero16();
        const LAS unsigned char* kp = lds + NSA_KB + buf * 16384 + kt * 8192 + lane * 16;
#pragma unroll
        for (int ks = 0; ks < 8; ++ks) s[kt] = mfma32(*(const LAS bf16x8*)(kp + ks * 1024), qf[ks], s[kt]); }
}
template <int MODE>
__device__ __forceinline__ void nsa_tile(LAS unsigned char* lds, int buf, int idx, int qb, int w, int lane_in, f32x16 (&s)[2], f32x16 (&O)[4], float& mrun, float& lrun,
                                         float m_fin, float invl, unsigned long long mysel, bool do_next, int bufn, const bf16x8 (&qf)[8], f32x16 (&sn)[2]) {
    const int lane = opaque_i(lane_in); const int r32 = lane & 31, hi = lane >> 5, hd = lane & 3, tl = (lane & 31) >> 2;
    const int tokq = 64 * qb + 8 * w + tl;
    LAS float* biasl = (LAS float*)(lds + NSA_BIAS);
    const float c1 = 0.08838834764831845f * LOG2E;
    int relbase, relmax; bool lanevalid = true, far; constexpr int kstride = (MODE <= 1) ? 16 : 1;
    if (MODE <= 1) { relbase = tokq - 31 - 1024 * idx; relmax = 1 << 30; far = false; }
    else if (MODE == 2) { relbase = tokq - 64 * idx; relmax = 512; far = (idx <= qb - 3) && (idx >= qb - 7); }
    else { relbase = tokq - 64 * idx; relmax = 1 << 30; far = (idx <= qb - 3); lanevalid = (mysel >> idx) & 1ull; }
    float cs = 1.0f, offl = 0.0f;
    if (far) {
        cs = c1; offl = lanevalid ? biasl[hd * 132 + 128] : -1e30f;
    } else {
#pragma unroll
        for (int kt = 0; kt < 2; ++kt)
#pragma unroll
            for (int hf = 0; hf < 2; ++hf) {
                float bv[8];
#pragma unroll
                for (int r8 = 0; r8 < 8; ++r8) { const int r = 8 * hf + r8; const int kk = 32 * kt + (r & 3) + 8 * (r >> 2) + 4 * hi; const int rel = relbase - kstride * kk;
                    const int ri = rel < 0 ? 0 : (rel > 128 ? 128 : rel); bv[r8] = biasl[hd * 132 + ri]; }
#pragma unroll
                for (int r8 = 0; r8 < 8; ++r8) asm volatile("" : "+v"(bv[r8]));
#pragma unroll
                for (int r8 = 0; r8 < 8; ++r8) { const int r = 8 * hf + r8; const int kk = 32 * kt + (r & 3) + 8 * (r >> 2) + 4 * hi; const int rel = relbase - kstride * kk;
                    const bool v = lanevalid && rel >= 0 && rel < relmax;
                    s[kt][r] = v ? s[kt][r] * c1 + bv[r8] : -1e30f; }
            }
    }
    { const LAS unsigned char* kp = lds + NSA_KB + bufn * 16384 + lane * 16;
#pragma unroll
      for (int kt = 0; kt < 2; ++kt) { sn[kt] = zero16();
#pragma unroll
          for (int ks = 0; ks < 8; ++ks) sn[kt] = mfma32(*(const LAS bf16x8*)(kp + kt * 8192 + ks * 1024), qf[ks], sn[kt]); } }
    if (MODE == 1) {
#pragma unroll
        for (int kt = 0; kt < 2; ++kt)
#pragma unroll
            for (int r = 0; r < 16; ++r) s[kt][r] = (s[kt][r] > -1e29f) ? __builtin_amdgcn_exp2f(s[kt][r] - m_fin) * invl : 0.f;
        LAS float* impa = (LAS float*)(lds + NSA_IMPA) + w * 8 * 66;
        LAS float* impb = (LAS float*)(lds + NSA_IMPB) + w * 8 * 66;
#pragma unroll
        for (int kt = 0; kt < 2; ++kt)
#pragma unroll
            for (int q = 0; q < 4; ++q) {
                float A_ = s[kt][4 * q] + s[kt][4 * q + 1] + s[kt][4 * q + 2] + 0.5f * s[kt][4 * q + 3], B_ = 0.5f * s[kt][4 * q + 3];
                A_ += __shfl_xor(A_, 1); A_ += __shfl_xor(A_, 2); B_ += __shfl_xor(B_, 1); B_ += __shfl_xor(B_, 2);
                const int j = 8 * (2 * idx + kt) + 2 * q + hi;
                if (hd == 0) { impa[tl * 66 + j] = A_; impb[tl * 66 + j + 1] = B_; }
            }
    } else {
        float tm = -3.0e38f;
#pragma unroll
        for (int kt = 0; kt < 2; ++kt)
#pragma unroll
            for (int r = 0; r < 16; r += 2) tm = fmaxf(fmaxf(tm, s[kt][r]), s[kt][r + 1]);
        tm = tm * cs + offl;
        tm = max_xor32(tm);
        const float mn = fmaxf(mrun, tm), al = __builtin_amdgcn_exp2f(mrun - mn); float ps = 0.f;
        const float om = offl - mn;
#pragma unroll
        for (int kt = 0; kt < 2; ++kt)
#pragma unroll
            for (int r = 0; r < 16; ++r) { const float p = __builtin_amdgcn_exp2f(s[kt][r] * cs + om); s[kt][r] = p; ps += p; }
        lrun = lrun * al + ps; mrun = mn;
        if (MODE != 0) {
            if (__builtin_amdgcn_ballot_w64(al != 1.0f)) {
#pragma unroll
                for (int dt = 0; dt < 4; ++dt) O[dt] = O[dt] * al;
            }
        }
    }
    if (MODE != 0) {
        __builtin_amdgcn_iglp_opt(0);
#pragma unroll
        for (int kt = 0; kt < 2; ++kt)
#pragma unroll
            for (int s2 = 0; s2 < 2; ++s2) {
                const bf16x8 pf = pack8(s[kt], s2);
#pragma unroll
                for (int dt = 0; dt < 4; ++dt) {
                    const LAS unsigned char* vp = lds + NSA_VB + buf * 16384 + (dt * 4 + 2 * kt + s2) * 1024 + lane * 16;
                    O[dt] = mfma32(*(const LAS bf16x8*)vp, pf, O[dt]);
                }
            }
    }
}
template <int MODE>
__device__ __forceinline__ void nsa_branch(unsigned char* ws, LAS unsigned char* lds, unsigned long long tmask, int b, int g, int qb, int w, int lane, const bf16x8 (&qf)[8], f32x16 (&O)[4],
                                           float& mrun, float& lrun, float m_fin, float invl, unsigned long long mysel) {
    int bc = 0;
    f32x16 sc[2];
    nsa_fill(lds, 0, nsa_src(ws, MODE, __builtin_ctzll(tmask), b, g));
    { const unsigned long long t1 = tmask & (tmask - 1); if (t1) nsa_fill(lds, 1, nsa_src(ws, MODE, __builtin_ctzll(t1), b, g)); }
    dma_wait_barrier();
    nsa_qk(lds, 0, lane, qf, sc);
    while (tmask) {
        const int idx = __builtin_ctzll(tmask); tmask &= tmask - 1;
        const unsigned long long t2 = tmask & (tmask - 1);
        const int bn = (bc == 2) ? 0 : bc + 1, bf = (bn == 2) ? 0 : bn + 1;
        if (t2) nsa_fill(lds, bf, nsa_src(ws, MODE, __builtin_ctzll(t2), b, g));
        f32x16 sn[2];
        nsa_tile<MODE>(lds, bc, idx, qb, w, lane, sc, O, mrun, lrun, m_fin, invl, mysel, tmask != 0ull, bn, qf, sn);
        dma_wait_barrier();
        if (tmask) { sc[0] = sn[0]; sc[1] = sn[1]; }
        bc = bn;
    }
}
__device__ __forceinline__ void nsa_accum(bf16_t* yrow, const f32x16 (&O)[4], float f, bool first) {
    u32x2 o[4][4];
#pragma unroll
    for (int dt = 0; dt < 4; ++dt)
#pragma unroll
        for (int q = 0; q < 4; ++q) { if (first) { o[dt][q].x = 0u; o[dt][q].y = 0u; } else o[dt][q] = *(const u32x2*)(yrow + 32 * dt + 8 * q); }
    __builtin_amdgcn_sched_barrier(0);
#pragma unroll
    for (int dt = 0; dt < 4; ++dt)
#pragma unroll
        for (int q = 0; q < 4; ++q) {
            u32x2 v = o[dt][q];
            v.x = cvt_pk_bf16(bflo(v.x) + f * O[dt][4 * q], bfhi(v.x) + f * O[dt][4 * q + 1]); v.y = cvt_pk_bf16(bflo(v.y) + f * O[dt][4 * q + 2], bfhi(v.y) + f * O[dt][4 * q + 3]);
            *(u32x2*)(yrow + 32 * dt + 8 * q) = v; }
}
__device__ __forceinline__ void nsa_finish(const Args& a, int b, int g, int qb, int br, const f32x16 (&O)[4], float scale, bool first) {
    const int tx = opaque_i(threadIdx.x); const int lane = tx & 63, w = tx >> 6; const int r32 = lane & 31, hi = lane >> 5, tl = r32 >> 2, hd = r32 & 3;
    const size_t grow = (size_t)b * SEQ + 64 * qb + 8 * w + tl;
    const bf16_t* PROJ = (const bf16_t*)(a.ws + WS_BIG);
    const float gate = sigmoid_f(bf2f(PROJ[grow * PROJ_LD + PC_GATE + (4 * g + hd) * 3 + br]));
    bf16_t* yrow = (bf16_t*)(a.ws + WS_XN) + grow * DM + 1024 + (4 * g + hd) * 128 + 4 * hi;
    nsa_accum(yrow, O, gate * scale, first);
}
__device__ __forceinline__ void nsa_item(const Args& a, LAS unsigned char* lds, int b, int g, int qb) {
    const int tid = opaque_i(threadIdx.x), w = tid >> 6, lane = tid & 63, r32 = lane & 31, hi = lane >> 5, tl = r32 >> 2, hd = r32 & 3;
    unsigned char* ws = a.ws;
    const bf16_t* PROJ = (const bf16_t*)(ws + WS_BIG);
    const int tokq = 64 * qb + 8 * w + tl;
    const size_t grow = (size_t)b * SEQ + tokq;
    LAS float* biasl = (LAS float*)(lds + NSA_BIAS);
    LAS float* impa = (LAS float*)(lds + NSA_IMPA) + w * 8 * 66;
    LAS float* impb = (LAS float*)(lds + NSA_IMPB) + w * 8 * 66;
    for (int i = tid; i < 4 * 129; i += 512) { const int hh = i / 129, rel = i - hh * 129; biasl[hh * 132 + rel] = a.in[19][(4 * g + hh) * 32 + t5_bucket_dev(rel)] * LOG2E; }
    for (int i = tid; i < 2 * 8 * 8 * 66; i += 512) ((LAS float*)(lds + NSA_IMPA))[i] = 0.f;
    const int nc = (4 * qb + 2) / 64 + 1;
    bf16x8 qf[8];
    { const bf16_t* qrow = PROJ + grow * PROJ_LD + PC_NQ + (4 * g + hd) * 128 + 8 * hi;
#pragma unroll
      for (int ks = 0; ks < 8; ++ks) qf[ks] = ld_frag(qrow + 16 * ks); }
    f32x16 O[4];
#pragma unroll
    for (int dt = 0; dt < 4; ++dt) O[dt] = zero16();
    float mrun = -1e30f, lrun = 0.f;
    __syncthreads();
    const unsigned long long cmask = (1ull << nc) - 1ull;
    if (__builtin_amdgcn_readfirstlane(w) < 4) __builtin_amdgcn_s_setprio(2);
    nsa_branch<0>(ws, lds, cmask, b, g, qb, w, lane, qf, O, mrun, lrun, 0.f, 0.f, 0ull);
    const float m_fin = mrun; const float invl = fast_rcp(lrun + __shfl_xor(lrun, 32));
    mrun = -1e30f; lrun = 0.f;
    nsa_branch<1>(ws, lds, cmask, b, g, qb, w, lane, qf, O, mrun, lrun, m_fin, invl, 0ull);
    nsa_finish(a, b, g, qb, 0, O, 1.0f, true);
    unsigned long long mysel, U;
    { const int tk = lane >> 3, jj = lane & 7; float sc[8];
#pragma unroll
      for (int q = 0; q < 8; ++q) { const int j = jj * 8 + q; const float v = impa[tk * 66 + j] + impb[tk * 66 + j];
          const bool forced = (j == 0) || (j == qb) || (j == qb - 1); sc[q] = forced ? 1e4f : (j <= qb ? v : -1e30f); }
      __syncthreads();
#pragma unroll
      for (int q = 0; q < 8; ++q) impa[tk * 66 + jj * 8 + q] = sc[q];
      __syncthreads();
      int rank[8];
#pragma unroll
      for (int q = 0; q < 8; ++q) rank[q] = 0;
      for (int ii = 0; ii < 64; ++ii) { const float vi = impa[tk * 66 + ii];
#pragma unroll
          for (int q = 0; q < 8; ++q) rank[q] += ((vi > sc[q]) || (vi == sc[q] && ii < jj * 8 + q)) ? 1 : 0; }
      unsigned bits = 0;
#pragma unroll
      for (int q = 0; q < 8; ++q) bits |= ((rank[q] < 16 && sc[q] > -5e29f) ? 1u : 0u) << q;
      ((LAS unsigned char*)(lds + NSA_SELM))[(8 * w + tk) * 8 + jj] = (unsigned char)bits; }
    __syncthreads();
    { const LAS unsigned long long* sm = (const LAS unsigned long long*)(lds + NSA_SELM);
      const int t2 = opaque_i(threadIdx.x);
      mysel = sm[8 * (t2 >> 6) + ((t2 & 31) >> 2)];
      unsigned long long u = sm[t2 & 63];
#pragma unroll
      for (int o = 32; o >= 1; o >>= 1) u |= __shfl_xor(u, o);
      U = u; }
#pragma unroll
    for (int dt = 0; dt < 4; ++dt) O[dt] = zero16();
    mrun = -1e30f; lrun = 0.f;
    { const int t0 = qb > 8 ? qb - 8 : 0; const unsigned long long wmask = ((qb == 63) ? ~0ull : ((1ull << (qb + 1)) - 1ull)) & ~((1ull << t0) - 1ull);
      nsa_branch<2>(ws, lds, wmask, b, g, qb, w, lane, qf, O, mrun, lrun, 0.f, 0.f, 0ull); }
    nsa_finish(a, b, g, qb, 2, O, fast_rcp(lrun + __shfl_xor(lrun, 32)), false);
#pragma unroll
    for (int dt = 0; dt < 4; ++dt) O[dt] = zero16();
    mrun = -1e30f; lrun = 0.f;
    { const unsigned long long smask = U & ((qb == 63) ? ~0ull : ((1ull << (qb + 1)) - 1ull));
      nsa_branch<3>(ws, lds, smask, b, g, qb, w, lane, qf, O, mrun, lrun, 0.f, 0.f, mysel); }
    nsa_finish(a, b, g, qb, 1, O, fast_rcp(lrun + __shfl_xor(lrun, 32)), false);
    __builtin_amdgcn_s_setprio(0);
    __syncthreads();
}

__device__ __forceinline__ void phase5(const Args& a, LAS unsigned char* lds) {
    const int bid = blockIdx.x, G = gridDim.x;
    if (G == 256) {
        if (bid < 128) { compress_item(a, lds, bid); ret_u_item(a, lds, 384 + bid); }
        else { for (int k = 0; k < 3; ++k) ret_u_item(a, lds, (bid - 128) + 128 * k); }
    } else for (int it = bid; it < 128 + 512; it += G) { if (it < 128) compress_item(a, lds, it); else ret_u_item(a, lds, it - 128); }
}
__device__ __forceinline__ void phase6(const Args& a, LAS unsigned char* lds) { ret_scan(a); }
template <int WHICH> __device__ __forceinline__ void phase7(const Args& a, LAS unsigned char* lds) {
    const int G = gridDim.x;
    if (WHICH & 1) for (int it = blockIdx.x; it < 512; it += G) {
        const int round = it / G, x = it % G; int qb, bg;
        if (G == 256) { bg = x & 7; qb = (round == 0) ? 63 - (x >> 3) : (x >> 3); } else { bg = it & 7; qb = 63 - (it >> 3); }
        nsa_item(a, lds, bg >> 1, bg & 1, qb);
    }
    if (WHICH & 2) for (int it = blockIdx.x; it < 512; it += G) ret_y_item(a, lds, it);
}

#define XB_TMO      128
#define XB_XCNT(j)  (256  + 64 * (j))
#define XB_XSUB(j)  (1280 + 64 * (j))
#define XB_XGEN(j)  (2304 + 64 * (j))
#define XB_TOP      3328
#define XB_TOPGEN   3392
#define XCD_BAR_WORDS 3456
#define XB_SPIN_CAP (1u << 18)

__device__ __forceinline__ unsigned xb_ld(unsigned* p)              { return __hip_atomic_load(p, __ATOMIC_RELAXED, __HIP_MEMORY_SCOPE_AGENT); }
__device__ __forceinline__ unsigned xb_add(unsigned* p, unsigned v) { return __hip_atomic_fetch_add(p, v, __ATOMIC_RELAXED, __HIP_MEMORY_SCOPE_AGENT); }
__device__ __forceinline__ unsigned xb_xcc_id() { return (unsigned)__builtin_amdgcn_s_getreg((3 << 11) | 20) & 0xFu; }
#define XB_SPIN(cond, bar) do { unsigned _sp = 0; while (cond) { __builtin_amdgcn_s_sleep(1); \
    if ((++_sp & 255u) == 0u) { if (xb_ld(&(bar)[XB_TMO])) break; if (_sp > XB_SPIN_CAP) { atomicAdd(&(bar)[XB_TMO], 1u); break; } } } } while (0)

struct XcdBarrier {
    unsigned* bar; unsigned x;
    volatile LAS unsigned* st;
};

__device__ __forceinline__ XcdBarrier xcd_barrier_post(unsigned* bar, volatile LAS unsigned* st) {
    XcdBarrier b; b.bar = bar; b.x = xb_xcc_id(); b.st = st;
    if (threadIdx.x == 0) (void)xb_add(&bar[XB_XCNT(b.x)], 1u);
    return b;
}
__device__ __forceinline__ void xcd_barrier_complete(unsigned* bar, unsigned x, unsigned& nloc, unsigned& nx) {
    const unsigned G = gridDim.x * gridDim.y * gridDim.z;
    unsigned sum, cnt, mine, sp = 0u;
    for (;;) {
        sum = 0u; cnt = 0u; mine = 0u;
#pragma unroll
        for (unsigned j = 0; j < 16; ++j) { const unsigned c = xb_ld(&bar[XB_XCNT(j)]); sum += c; cnt += (c > 0u) ? 1u : 0u; mine = (j == x) ? c : mine; }
        if (sum == G) break;
        __builtin_amdgcn_s_sleep(1);
        if ((++sp & 255u) == 0u) { if (xb_ld(&bar[XB_TMO])) break; if (sp > XB_SPIN_CAP) { atomicAdd(&bar[XB_TMO], 1u); break; } }
    }
    nloc = mine > 0u ? mine : 1u; nx = cnt > 0u ? cnt : 1u;
}

__device__ __forceinline__ void xcd_barrier(const XcdBarrier& b) {
    asm volatile("s_waitcnt vmcnt(0)" ::: "memory");
    __syncthreads();
    if (threadIdx.x == 0) {
        unsigned* bar = b.bar;
        __builtin_amdgcn_s_waitcnt(0);
        unsigned nloc = b.st[0], nx = b.st[1];
        if (nloc == 0u) { xcd_barrier_complete(bar, b.x, nloc, nx); b.st[0] = nloc; b.st[1] = nx; }
        const unsigned old = xb_add(&bar[XB_XSUB(b.x)], 1u);
        const unsigned gen = old / nloc;
        if (old + 1u == (gen + 1u) * nloc) {
            __builtin_amdgcn_fence(__ATOMIC_RELEASE, "agent");
            asm volatile("s_waitcnt vmcnt(0)" ::: "memory");
            const unsigned og = xb_add(&bar[XB_TOP], 1u);
            const unsigned tg = og / nx;
            if (og + 1u == (tg + 1u) * nx) xb_add(&bar[XB_TOPGEN], 1u);
            else XB_SPIN(xb_ld(&bar[XB_TOPGEN]) == tg, bar);
            __builtin_amdgcn_fence(__ATOMIC_ACQUIRE, "agent");
            xb_add(&bar[XB_XGEN(b.x)], 1u);
            asm volatile("s_waitcnt vmcnt(0)" ::: "memory");
        } else {
            XB_SPIN(xb_ld(&bar[XB_XGEN(b.x)]) == gen, bar);
            __builtin_amdgcn_fence(__ATOMIC_ACQUIRE, "agent");
            asm volatile("s_waitcnt vmcnt(0)" ::: "memory");
        }
    }
    __syncthreads();
}

constexpr int LDS_BYTES = 147456;
constexpr int NPHASE = 13;

__global__ void __launch_bounds__(512, 2) mk_fwd(Args a) {
    extern __shared__ __attribute__((aligned(16))) unsigned char lds_raw[];
    LAS unsigned char* lds = (LAS unsigned char*)lds_raw;
    cg::grid_group grid = cg::this_grid();
    unsigned char* ws = a.ws;
    const int tid = threadIdx.x, bid = blockIdx.x, G = gridDim.x;
    bf16_t* XN = (bf16_t*)(ws + WS_XN);
    bf16_t* X1B = (bf16_t*)a.out; bf16_t* X2B = (bf16_t*)a.out + (size_t)NTOK * DM;
    volatile LAS unsigned* bst = (volatile LAS unsigned*)(lds + LDS_BYTES - 64);
    if (tid < 2) bst[tid] = 0u;
    __syncthreads();
    XcdBarrier bar = xcd_barrier_post((unsigned*)ws, bst);
    if (a.ph_lo < 0) grid.sync();
#define PH_ON(k) (a.ph_lo <= (k) && (k) < a.ph_hi)
#define PH_END(k) if ((k) + 1 < a.ph_hi) { xcd_barrier(bar); }
#ifndef MK_REPEAT
#define MK_REPEAT 0
#endif
#define REP(k) for (int rep_ = 0; rep_ < (((MK_REPEAT >> (k)) & 1) ? 2 : 1); ++rep_)
    {
        if (PH_ON(0)) REP(0) {
            { LAS float* tile = (LAS float*)lds; f32x4 v[8]; int it = bid;
              if (it < 3364) wconv_load(p0_witem(it, a.in, ws), v);
              while (it < 3364) { wconv_commit(v, tile); __syncthreads(); const int nx = it + G; if (nx < 3364) wconv_load(p0_witem(nx, a.in, ws), v);
                  wconv_drain(p0_witem(it, a.in, ws), tile); __syncthreads(); it = nx; } }
            { float* rot = (float*)(ws + WS_ROT); float* rott = (float*)(ws + WS_ROTT);
              for (int idx = bid * 512 + tid; idx < SEQ * 128; idx += G * 512) {
                  const int pos = idx >> 7, dd = idx & 127;
                  const float inv = exp2f(-((float)dd * (1.0f / 128.0f)) * 13.287712379549449f);
                  const float ang = (float)pos * inv;
                  double r = (double)ang * 0.15915494309189535; r -= floor(r); const float rf = (float)r;
                  const float cs = __builtin_amdgcn_cosf(rf), sn = __builtin_amdgcn_sinf(rf);
                  rot[idx] = cs; rot[SEQ * 128 + idx] = sn; rott[dd * SEQ + pos] = cs; rott[128 * SEQ + dd * SEQ + pos] = sn;
              } }
            { float* ssq = (float*)(ws + WS_SSQ); for (int i = bid * 512 + tid; i < 3 * NTOK; i += G * 512) ssq[i] = 0.f; }
            rms_rows_bf16(a.in[0], a.in[1], XN);
            PH_END(0)
        }
        if (PH_ON(1)) REP(1) {
            pg8::StaticOrder S; S.init(XN, ws + WS_W13T, NTOK, 2 * DFF, DM, G, bid);
            EpiSwiglu E; E.O = (bf16_t*)(ws + WS_BIG); E.ldc = DFF; E.ssq = nullptr;
            pg8::gemm_phase<EpiSwiglu, pg8::StaticOrder>(lds, DM, S, E);
            PH_END(1)
        }
        if (PH_ON(2)) REP(2) {
            pg8::StaticOrder S; S.init(ws + WS_BIG, ws + WS_W2T, NTOK, DM, DFF, G, bid);
            EpiResid E; E.R = a.in[0]; E.Rb = nullptr; E.scale = 0.5f; E.Xb = X1B; E.ssq = (float*)(ws + WS_SSQ);
            pg8::gemm_phase<EpiResid, pg8::StaticOrder>(lds, DFF, S, E);
            PH_END(2)
        }
        if (PH_ON(4)) REP(4) {
            WinOrder S; S.XN = (const char*)X1B; S.WT = (const char*)(ws + WS_WINT); S.G = G; S.c = bid; S.tstep = (size_t)256 * DM * 2;
            EpiProj E; E.ws = ws;
            pg8::gemm_phase<EpiProj, WinOrder>(lds, DM, S, E);
            { LAS float* tile = (LAS float*)lds; f32x4 v[8];
              const int extra = (G == 256 && bid >= 192) ? 7 : 0, base = (G == 256) ? 448 : 0;
              const int nrest = (2112 - base - bid + G - 1) / G > 0 ? (2112 - base - bid + G - 1) / G : 0, nit = extra + nrest;
#define MK_WIDX(j) ((j) < extra ? (bid - 192) * 7 + (j) : base + bid + G * ((j) - extra))
              __syncthreads();
              if (nit > 0) wconv_load<true>(ffn_witem(MK_WIDX(0), a.in[16], a.in[17], a.in[18], ws, a.in[15]), v);
              for (int j = 0; j < nit; ++j) { wconv_commit(v, tile); __syncthreads(); if (j + 1 < nit) wconv_load<true>(ffn_witem(MK_WIDX(j + 1), a.in[16], a.in[17], a.in[18], ws, a.in[15]), v);
                  wconv_drain<true>(ffn_witem(MK_WIDX(j), a.in[16], a.in[17], a.in[18], ws, a.in[15]), tile); __syncthreads(); }
#undef MK_WIDX
            }
            PH_END(4)
        }
        if (PH_ON(5)) REP(5) { phase5(a, lds); PH_END(5) }
        if (PH_ON(6)) { phase6(a, lds); PH_END(6) }
        if (PH_ON(7)) REP(7) { phase7<3>(a, lds); PH_END(7) }
        if (PH_ON(8) && MK_DO8) {
            pg8::StaticOrder S; S.init(XN, ws + WS_WOUTT, NTOK, DM, DM, G, bid);
            EpiResid E; E.R = nullptr; E.Rb = X1B; E.scale = 1.0f; E.Xb = X2B; E.ssq = (float*)(ws + WS_SSQ) + NTOK;
            pg8::gemm_phase<EpiResid, pg8::StaticOrder>(lds, DM, S, E);
            PH_END(8)
        }
        if (PH_ON(10)) {
            pg8::StaticOrder S; S.init(X2B, ws + WS_W13T, NTOK, 2 * DFF, DM, G, bid);
            EpiSwiglu E; E.O = (bf16_t*)(ws + WS_BIG); E.ldc = DFF; E.ssq = (const float*)(ws + WS_SSQ) + NTOK;
            pg8::gemm_phase<EpiSwiglu, pg8::StaticOrder>(lds, DM, S, E);
            PH_END(10)
        }
        if (PH_ON(11)) {
            pg8::StaticOrder S; S.init(ws + WS_BIG, ws + WS_W2T, NTOK, DM, DFF, G, bid);
            EpiResid E; E.R = nullptr; E.Rb = X2B; E.scale = 0.5f; E.Xb = XN; E.ssq = (float*)(ws + WS_SSQ) + 2 * NTOK;
            pg8::gemm_phase<EpiResid, pg8::StaticOrder>(lds, DFF, S, E);
            PH_END(11)
        }
#ifdef MK_EXTRA_SYNCS
        if (PH_ON(12)) { for (int i_ = 0; i_ < MK_EXTRA_SYNCS; ++i_) xcd_barrier(bar); }
#endif
        if (PH_ON(12)) rms_final_from_bf16(XN, (const float*)(ws + WS_SSQ) + 2 * NTOK, a.in[20], a.out);
#ifdef MK_EXTRA_PHASE
        if (PH_ON(13)) phase7<1>(a, lds);
        if (PH_ON(14)) phase7<2>(a, lds);
#endif
    }
}

extern "C" void kernel_launch(void* const* d_in, const int* in_sizes, int n_in, void* d_out, int out_size, void* d_ws, size_t ws_size, hipStream_t stream) {
    static int grid = 0;
    if (grid == 0) {
        if (n_in != 21 || out_size != NTOK * DM || ws_size < WS_END) { fprintf(stderr, "kernel_launch: unexpected shapes (n_in %d out %d ws %zu need %zu)\n", n_in, out_size, ws_size, (size_t)WS_END); grid = -1; return; }
        int dev = 0, cus = 0, per_cu = 0;
        hipGetDevice(&dev); hipDeviceGetAttribute(&cus, hipDeviceAttributeMultiprocessorCount, dev);
        if (hipFuncSetAttribute((const void*)mk_fwd, hipFuncAttributeMaxDynamicSharedMemorySize, LDS_BYTES) != hipSuccess) { fprintf(stderr, "kernel_launch: hipFuncSetAttribute failed\n"); grid = -1; return; }
        hipOccupancyMaxActiveBlocksPerMultiprocessor(&per_cu, (const void*)mk_fwd, 512, LDS_BYTES);
        if (per_cu < 1) { fprintf(stderr, "kernel_launch: occupancy query says %d blocks/CU\n", per_cu); per_cu = 1; }
        (void)hipGetLastError();
        grid = cus;
    }
    if (grid < 0) return;
    Args a{};
    for (int i = 0; i < 21; ++i) a.in[i] = (const float*)d_in[i];
    a.out = (float*)d_out; a.ws = (unsigned char*)d_ws;
#if MK_SPLIT
    for (int ph = 0; ph < NPHASE; ++ph) { a.ph_lo = ph; a.ph_hi = ph + 1; void* args[] = {&a};
        hipLaunchCooperativeKernel((const void*)mk_fwd, dim3(grid), dim3(512), args, LDS_BYTES, stream); }
#else
    a.ph_lo = 0; a.ph_hi = NPHASE;
    (void)hipMemsetAsync(d_ws, 0, 16384, stream);
    void* args[] = {&a};
    hipError_t e = hipLaunchCooperativeKernel((const void*)mk_fwd, dim3(grid), dim3(512), args, LDS_BYTES, stream);
    if (e != hipSuccess) fprintf(stderr, "cooperative launch failed: %s (grid %d)\n", hipGetErrorString(e), grid);
#ifdef MK_EXTRA_PHASE
    { Args a2 = a; a2.ph_lo = MK_EXTRA_PHASE; a2.ph_hi = MK_EXTRA_PHASE + 1; void* args2[] = {&a2}; hipLaunchCooperativeKernel((const void*)mk_fwd, dim3(grid), dim3(512), args2, LDS_BYTES, stream); }
#endif
#endif
}
```
